# Optimizing an MI355X kernel written in HIP

```python
import math
import jax, jax.numpy as jnp
from jax import lax
import numpy as np

D_MODEL = 1024
BATCH = 4
SEQ = 4096
DEPTH = 4

N_MIXERS = 2
N_SSM_LAYERS = (DEPTH + 1) // 2
N_ATTN_LAYERS = DEPTH // 2
SSM_EXPAND = 2
D_INNER = SSM_EXPAND * D_MODEL
SSM_HEAD_DIM = 64
SSM_HEADS = D_INNER // SSM_HEAD_DIM
SSM_GROUPS = 8
SSM_STATE = 128
SSM_CONV = 4
SSM_CHUNK = 128
SSM_CONV_DIM = D_INNER + 2 * SSM_GROUPS * SSM_STATE
SSM_IN_DIM = 2 * D_INNER + 2 * SSM_GROUPS * SSM_STATE + SSM_HEADS
ATTN_HEAD_DIM = 64
ATTN_HEADS = D_MODEL // (2 * ATTN_HEAD_DIM)
ATTN_V_DIM = 2 * ATTN_HEAD_DIM
Q_BLOCK = 128
D_FF = 2816
FFN_CONV = 3
RMS_EPS = 1e-6

kernel_name = "hybrid_ssd_diffattn_convffn"


def rmsnorm(x, g):
    xf = x.astype(jnp.float32)
    y = xf * lax.rsqrt(jnp.mean(xf * xf, axis=-1, keepdims=True) + RMS_EPS)
    return (y * g.astype(jnp.float32)).astype(x.dtype)


def causal_dwconv(x, w, b):
    k_w = w.shape[0]
    s = x.shape[1]
    xp = jnp.pad(x, ((0, 0), (k_w - 1, 0), (0, 0)))
    y = xp[:, 0:s] * w[0]
    for k in range(1, k_w):
        y = y + xp[:, k:k + s] * w[k]
    return y + b


def ssd_chunked(xh, dA, Bm, Cm):
    b, s, h, p = xh.shape
    g, n = Bm.shape[2], Bm.shape[3]
    r = h // g
    l = SSM_CHUNK
    c = s // l
    x = xh.reshape(b, c, l, g, r, p)
    A = dA.reshape(b, c, l, g, r).transpose(0, 1, 3, 4, 2)
    Bc = Bm.reshape(b, c, l, g, n)
    Cc = Cm.reshape(b, c, l, g, n)
    A_cs = jnp.cumsum(A, axis=-1)
    causal = jnp.tril(jnp.ones((l, l), dtype=bool))
    seg = A_cs[..., :, None] - A_cs[..., None, :]
    L = jnp.exp(jnp.where(causal, seg, -jnp.inf))
    CB = jnp.einsum('bclgn,bcsgn->bcgls', Cc, Bc)
    y_diag = jnp.einsum('bcgls,bcgrls,bcsgrp->bclgrp', CB, L, x)
    decay = jnp.exp(A_cs[..., -1:] - A_cs)
    states = jnp.einsum('bcsgn,bcgrs,bcsgrp->bcgrpn', Bc, decay, x)
    chunk_decay = jnp.exp(A_cs[..., -1])

    def step(carry, inp):
        st, dec = inp
        return carry * dec[..., None, None] + st, carry

    init = jnp.zeros_like(states[:, 0])
    _, prev = lax.scan(step, init, (states.transpose(1, 0, 2, 3, 4, 5),
                                    chunk_decay.transpose(1, 0, 2, 3)))
    prev = prev.transpose(1, 0, 2, 3, 4, 5)
    y_off = jnp.einsum('bclgn,bcgrpn,bcgrl->bclgrp', Cc, prev, jnp.exp(A_cs))
    return (y_diag + y_off).reshape(b, s, h, p)


def mamba2_mixer(u, w_in, conv_w, conv_b, dt_bias, A_log, D_skip, norm_g, w_out):
    b, s, _ = u.shape
    f32 = jnp.float32
    proj = jnp.einsum('bsd,de->bse', u, w_in)
    z, xBC, dt = jnp.split(proj, [D_INNER, D_INNER + SSM_CONV_DIM], axis=-1)
    xBC = jax.nn.silu(causal_dwconv(xBC, conv_w, conv_b))
    xs, Bm, Cm = jnp.split(xBC, [D_INNER, D_INNER + SSM_GROUPS * SSM_STATE], axis=-1)
    xs = xs.reshape(b, s, SSM_HEADS, SSM_HEAD_DIM).astype(f32)
    Bm = Bm.reshape(b, s, SSM_GROUPS, SSM_STATE).astype(f32)
    Cm = Cm.reshape(b, s, SSM_GROUPS, SSM_STATE).astype(f32)
    dt = jax.nn.softplus(dt.astype(f32) + dt_bias.astype(f32))
    A = -jnp.exp(A_log.astype(f32))
    y = ssd_chunked(xs * dt[..., None], dt * A, Bm, Cm)
    y = y + xs * D_skip.astype(f32)[:, None]
    y = y.reshape(b, s, D_INNER) * jax.nn.silu(z.astype(f32))
    yg = y.reshape(b, s, SSM_GROUPS, D_INNER // SSM_GROUPS)
    yg = yg * lax.rsqrt(jnp.mean(yg * yg, axis=-1, keepdims=True) + RMS_EPS)
    y = yg.reshape(b, s, D_INNER) * norm_g.astype(f32)
    return jnp.einsum('bse,ed->bsd', y.astype(u.dtype), w_out)


def alibi_slopes(h):
    return jnp.exp2(-8.0 * jnp.arange(1, h + 1, dtype=jnp.float32) / h)


def diff_attention(u, w_qkv, lq1, lk1, lq2, lk2, subln_g, w_out, lambda_init):
    b, s, _ = u.shape
    f32 = jnp.float32
    H, dh = ATTN_HEADS, ATTN_HEAD_DIM
    qkv = jnp.einsum('bsd,de->bse', u, w_qkv)
    q, k, v = jnp.split(qkv, 3, axis=-1)
    q = q.reshape(b, s, H, 2, dh)
    k = k.reshape(b, s, H, 2, dh)
    v = v.reshape(b, s, H, ATTN_V_DIM)
    lam = (jnp.exp(jnp.sum(lq1.astype(f32) * lk1.astype(f32)))
           - jnp.exp(jnp.sum(lq2.astype(f32) * lk2.astype(f32))) + lambda_init)
    scale = dh ** -0.5
    slopes = alibi_slopes(H)
    kpos = jnp.arange(s)
    n_blk = s // Q_BLOCK

    def block(i):
        start = i * Q_BLOCK
        qb = lax.dynamic_slice_in_dim(q, start, Q_BLOCK, axis=1)
        sc = jnp.einsum('bqhtd,bkhtd->bhtqk', qb, k).astype(f32) * scale
        qpos = start + jnp.arange(Q_BLOCK)
        dist = (qpos[:, None] - kpos[None, :]).astype(f32)
        bias = -slopes[:, None, None, None] * dist
        sc = jnp.where(dist >= 0, sc + bias, -jnp.inf)
        pr = jax.nn.softmax(sc, axis=-1)
        a = pr[:, :, 0] - lam * pr[:, :, 1]
        return jnp.einsum('bhqk,bkhe->bqhe', a.astype(v.dtype), v)

    out = lax.map(block, jnp.arange(n_blk))
    out = out.transpose(1, 0, 2, 3, 4).reshape(b, s, H, ATTN_V_DIM)
    out = rmsnorm(out, subln_g) * (1.0 - lambda_init)
    return jnp.einsum('bse,ed->bsd', out.reshape(b, s, H * ATTN_V_DIM), w_out)


def conv_ffn(u, w_up, conv_w, conv_b, w_down):
    h = jnp.einsum('bsd,df->bsf', u, w_up)
    h = causal_dwconv(h, conv_w, conv_b)
    gate, up = jnp.split(h, 2, axis=-1)
    return jnp.einsum('bsf,fd->bsd', jax.nn.silu(gate) * up, w_down)


def setup_inputs(seed: int = 0) -> dict:
    key = jax.random.key(seed)
    ks = jax.random.split(key, 24)
    f32 = jnp.float32

    def nrm(k, shape, scale):
        return jax.random.normal(k, shape, f32) * scale

    NS, NA = N_SSM_LAYERS, N_ATTN_LAYERS
    dt0 = jnp.exp(jax.random.uniform(ks[4], (NS, SSM_HEADS), f32, math.log(1e-3), math.log(1e-1)))
    return {
        "x": nrm(ks[0], (BATCH, SEQ, D_MODEL), 1.0),
        "ssm_w_in": nrm(ks[1], (NS, D_MODEL, SSM_IN_DIM), D_MODEL ** -0.5),
        "ssm_conv_w": nrm(ks[2], (NS, SSM_CONV, SSM_CONV_DIM), SSM_CONV ** -0.5),
        "ssm_conv_b": nrm(ks[3], (NS, SSM_CONV_DIM), 0.02),
        "ssm_dt_bias": dt0 + jnp.log(-jnp.expm1(-dt0)),
        "ssm_A_log": jnp.log(jax.random.uniform(ks[5], (NS, SSM_HEADS), f32, 1.0, 16.0)),
        "ssm_D": 1.0 + nrm(ks[6], (NS, SSM_HEADS), 0.1),
        "ssm_norm_g": 1.0 + nrm(ks[7], (NS, D_INNER), 0.1),
        "ssm_w_out": nrm(ks[8], (NS, D_INNER, D_MODEL), D_INNER ** -0.5),
        "attn_w_qkv": nrm(ks[9], (NA, D_MODEL, 3 * D_MODEL), D_MODEL ** -0.5),
        "attn_lambda_q1": nrm(ks[10], (NA, ATTN_HEAD_DIM), 0.1),
        "attn_lambda_k1": nrm(ks[11], (NA, ATTN_HEAD_DIM), 0.1),
        "attn_lambda_q2": nrm(ks[12], (NA, ATTN_HEAD_DIM), 0.1),
        "attn_lambda_k2": nrm(ks[13], (NA, ATTN_HEAD_DIM), 0.1),
        "attn_subln_g": 1.0 + nrm(ks[14], (NA, ATTN_V_DIM), 0.1),
        "attn_w_out": nrm(ks[15], (NA, D_MODEL, D_MODEL), D_MODEL ** -0.5),
        "norm_mix_pre": 1.0 + nrm(ks[16], (DEPTH, D_MODEL), 0.1),
        "norm_mix_post": 1.0 + nrm(ks[17], (DEPTH, D_MODEL), 0.1),
        "norm_ffn_pre": 1.0 + nrm(ks[18], (DEPTH, D_MODEL), 0.1),
        "norm_ffn_post": 1.0 + nrm(ks[19], (DEPTH, D_MODEL), 0.1),
        "ffn_w_up": nrm(ks[20], (DEPTH, D_MODEL, 2 * D_FF), D_MODEL ** -0.5),
        "ffn_conv_w": nrm(ks[21], (DEPTH, FFN_CONV, 2 * D_FF), FFN_CONV ** -0.5),
        "ffn_conv_b": nrm(ks[22], (DEPTH, 2 * D_FF), 0.02),
        "ffn_w_down": nrm(ks[23], (DEPTH, D_FF, D_MODEL), D_FF ** -0.5),
    }


def reference(x, ssm_w_in, ssm_conv_w, ssm_conv_b, ssm_dt_bias, ssm_A_log, ssm_D, ssm_norm_g,
              ssm_w_out, attn_w_qkv, attn_lambda_q1, attn_lambda_k1, attn_lambda_q2,
              attn_lambda_k2, attn_subln_g, attn_w_out, norm_mix_pre, norm_mix_post,
              norm_ffn_pre, norm_ffn_post, ffn_w_up, ffn_conv_w, ffn_conv_b, ffn_w_down):
    for i in range(DEPTH):
        j = i // N_MIXERS
        hn = rmsnorm(x, norm_mix_pre[i])
        if i % N_MIXERS == 0:
            m = mamba2_mixer(hn, ssm_w_in[j], ssm_conv_w[j], ssm_conv_b[j], ssm_dt_bias[j],
                             ssm_A_log[j], ssm_D[j], ssm_norm_g[j], ssm_w_out[j])
        else:
            lambda_init = 0.8 - 0.6 * math.exp(-0.3 * i)
            m = diff_attention(hn, attn_w_qkv[j], attn_lambda_q1[j], attn_lambda_k1[j],
                               attn_lambda_q2[j], attn_lambda_k2[j], attn_subln_g[j],
                               attn_w_out[j], lambda_init)
        x = x + rmsnorm(m, norm_mix_post[i])
        hn = rmsnorm(x, norm_ffn_pre[i])
        f = conv_ffn(hn, ffn_w_up[i], ffn_conv_w[i], ffn_conv_b[i], ffn_w_down[i])
        x = x + rmsnorm(f, norm_ffn_post[i])
    return x
```

```cpp
#include <hip/hip_runtime.h>
#include <hip/hip_cooperative_groups.h>
#include <cstdio>
#include <cstdint>
namespace cg = cooperative_groups;

#define DI __device__ __forceinline__
#define LAS __attribute__((address_space(3)))
typedef unsigned short bf16_t;
typedef short bf16x8 __attribute__((ext_vector_type(8)));
typedef short s16x4 __attribute__((ext_vector_type(4)));
typedef float f32x4 __attribute__((ext_vector_type(4)));
typedef float f32x16 __attribute__((ext_vector_type(16)));
typedef unsigned u32x4 __attribute__((ext_vector_type(4)));
typedef unsigned u32x2 __attribute__((ext_vector_type(2)));
typedef __bf16 bf16x2_t __attribute__((ext_vector_type(2)));
typedef float f32x2_t __attribute__((ext_vector_type(2)));

DI unsigned cvtpk(float lo, float hi) { f32x2_t v = {lo, hi}; bf16x2_t b = __builtin_convertvector(v, bf16x2_t); return __builtin_bit_cast(unsigned, b); }
DI float bflo(unsigned w) { return __uint_as_float(w << 16); }
DI float bfhi(unsigned w) { return __uint_as_float(w & 0xffff0000u); }
DI float bf1(bf16_t b) { return __uint_as_float((unsigned)b << 16); }
DI float silu_f(float x) { return x / (1.0f + __expf(-x)); }
DI float wave_sum(float v) {
#pragma unroll
    for (int o = 1; o < 64; o <<= 1) v += __shfl_xor(v, o);
    return v;
}
DI int crow(int reg, int h) { return (reg & 3) + 8 * (reg >> 2) + 4 * h; }
#define MFMA32(a, b, c) __builtin_amdgcn_mfma_f32_32x32x16_bf16((a), (b), (c), 0, 0, 0)
#define LDS_WAIT() asm volatile("s_waitcnt lgkmcnt(0)" ::: "memory")

constexpr int NB = 4, SEQ = 4096, DM = 1024, MROWS = NB * SEQ;
constexpr int DIN = 2048, NPROJ = 6144, NIN = 6176, NINP = 6400, DFF = 2816, NUP = 5632, NQKV = 3072, XBC = 4096;
constexpr float EPS = 1e-6f;
constexpr float LOG2E = 1.4426950408889634f;
constexpr size_t MiB = 1u << 20;
constexpr size_t WS_CD = 0;
constexpr size_t WS_DT = 1 * MiB;
constexpr size_t WS_W1 = 3 * MiB;
constexpr size_t WS_W2 = 16 * MiB;
constexpr size_t WS_XN = 22 * MiB;
constexpr size_t WS_M = 54 * MiB;
constexpr size_t WS_ST = 22 * MiB;
constexpr size_t WS_BIG = 86 * MiB;
constexpr size_t WS_ACT = 262 * MiB;
constexpr size_t WS_Y = 278 * MiB;
constexpr size_t WS_END = 350 * MiB;
constexpr int LDS_BYTES = 135168;

namespace pg8 {
#define PG8_LAS __attribute__((address_space(3)))
constexpr int BM = 256, BK = 64, HALF = 128, HTB = HALF * BK * 2  , STAGE_BYTES = 8 * HTB, NXCD = 8, WGM = 8;

__host__ __device__ __forceinline__ int lds_byte(int r, int c) { const int st = (r >> 4) * 2 + (c >> 5), rr = r & 15, cc = c & 31, ob = rr * 64 + cc * 2; return st * 1024 + (ob ^ (((ob >> 9) & 1) << 5)); }
__host__ __device__ __forceinline__ void stage_rc(int b, int& R, int& C) { const int st = b / 1024, sb = b % 1024, swz = sb ^ (((sb >> 9) & 1) << 5); R = (st >> 1) * 16 + swz / 64; C = (st & 1) * 32 + (swz % 64) / 2; }
__host__ __device__ __forceinline__ int perm32(int rho) { const int n = rho >> 4, i = rho & 15; return 8 * (i >> 2) + 4 * n + (i & 3); }

struct Unit { int pm, pn; };
struct Gemm { const bf16_t* A; const bf16_t* Bt; int M, N, K, lda; };

struct StaticOrder {
    int nM, nN, nwg, G, c;
    __host__ __device__ void init(int M, int N, int G_, int c_) { nM = M / BM; nN = N / BM; nwg = nM * nN; G = G_; c = c_; }
    __host__ __device__ bool next(int i, Unit& u) const {
        const long L = (long)i * G + c; if (L >= nwg) return false;
        int wgid = (int)L; { const int q = nwg / NXCD, r = nwg % NXCD, xcd = wgid % NXCD, off = wgid / NXCD; wgid = (xcd < r ? xcd * (q + 1) : r * (q + 1) + (xcd - r) * q) + off; }
        const int nig = WGM * nN, gid = wgid / nig, fm = gid * WGM, gsz = (nM - fm) < WGM ? (nM - fm) : WGM;
        u.pm = fm + ((wgid % nig) % gsz); u.pn = (wgid % nig) / gsz; return true;
    }
    __device__ __forceinline__ void a_ready(const Unit&) const {}
    __device__ __forceinline__ void done(const Unit&) const {}
};

template <class Epi, class Sched, bool ALIGN_EPI = false, bool SP2 = false>
__device__ __forceinline__ void gemm_phase(PG8_LAS unsigned char* lds, const Gemm g, const Sched& S, const Epi& E) {
    int tid_ = threadIdx.x; asm volatile("" : "+v"(tid_));
    const int tid = tid_, wid = __builtin_amdgcn_readfirstlane(tid >> 6), lane = tid & 63, wr = wid >> 2, wc = wid & 3, fr = lane & 15, fq = lane >> 4;
    const int K = g.K, nt = K / BK;
    unsigned voffA[2], voffB[2];
#pragma unroll
    for (int i = 0; i < 2; ++i) { int R, C; stage_rc(tid * 16 + i * 8192, R, C); const int Rb = Epi::PERM ? ((R & ~31) + perm32(R & 31)) : R;
        voffA[i] = (unsigned)(R * g.lda + C) * 2u; voffB[i] = (unsigned)(Rb * K + C) * 2u; }
    const size_t kstep = (size_t)(BK * 2);
    const size_t hstep = (size_t)HALF * K * 2;
    const size_t tstep = 2 * hstep; const size_t hstepA = (size_t)HALF * g.lda * 2, tstepA = 2 * hstepA;
    const unsigned ldsw = (unsigned)wid * 1024u;
    const int aoff = lds_byte(wr * 64 + fr, fq * 8), boff = lds_byte(wc * 32 + fr, fq * 8);
#define PG8_SA(b, h) (((b) * 2 + (h)) * HTB)
#define PG8_SB(b, h) ((4 + (b) * 2 + (h)) * HTB)
#define PG8_STAGE(bufoff, gbase, voff) do { _Pragma("unroll") for (int _i = 0; _i < 2; ++_i) \
        __builtin_amdgcn_global_load_lds((const unsigned*)((const char*)(gbase) + (voff)[_i]), (PG8_LAS unsigned*)(lds + (bufoff) + ldsw + _i * 8192), 16, 0, 0); } while (0)
#define PG8_LDA(dst, b, h) do { _Pragma("unroll") for (int m = 0; m < 4; ++m) _Pragma("unroll") for (int k = 0; k < 2; ++k) dst[m][k] = *(const PG8_LAS bf16x8*)(lds + PG8_SA(b, h) + aoff + m * 2048 + k * 1024); } while (0)
#define PG8_LDB(dst, b, h) do { _Pragma("unroll") for (int n = 0; n < 2; ++n) _Pragma("unroll") for (int k = 0; k < 2; ++k) dst[n][k] = *(const PG8_LAS bf16x8*)(lds + PG8_SB(b, h) + boff + n * 2048 + k * 1024); } while (0)
#define PG8_MMA(ai, bj, At, Bt) do { __builtin_amdgcn_s_setprio(1); _Pragma("unroll") for (int m = 0; m < 4; ++m) _Pragma("unroll") for (int n = 0; n < 2; ++n) _Pragma("unroll") for (int k = 0; k < 2; ++k) \
        acc[ai][bj][m][n] = __builtin_amdgcn_mfma_f32_16x16x32_bf16(Bt[n][k], At[m][k], acc[ai][bj][m][n], 0, 0, 0); __builtin_amdgcn_s_setprio(0); } while (0)
#define PG8_WAIT_V(n) asm volatile("s_waitcnt vmcnt(" #n ")" ::: "memory")
#define PG8_WAIT_L(n) asm volatile("s_waitcnt lgkmcnt(" #n ")" ::: "memory")
#define PG8_BAR __builtin_amdgcn_s_barrier()
#define PG8_SCHED __builtin_amdgcn_sched_barrier(0)
    Unit cur, nxt; int ui = 0;
    if (!S.next(0, cur)) return;
    f32x4 acc[2][2][4][2];
#pragma unroll
    for (int a = 0; a < 2; ++a)
#pragma unroll
        for (int b = 0; b < 2; ++b)
#pragma unroll
            for (int m = 0; m < 4; ++m)
#pragma unroll
                for (int n = 0; n < 2; ++n) acc[a][b][m][n] = (f32x4){0.f, 0.f, 0.f, 0.f};
    bf16x8 At[4][2], B0[2][2], B1[2][2];
    const char* cA = (const char*)g.A + (size_t)cur.pm * tstepA; const char* cB = (const char*)g.Bt + (size_t)cur.pn * tstep;
    S.a_ready(cur);
    if constexpr (SP2) {
        PG8_STAGE(PG8_SB(0, 0), cB, voffB); PG8_STAGE(PG8_SB(0, 1), cB + hstep, voffB); PG8_STAGE(PG8_SA(0, 0), cA, voffA); PG8_STAGE(PG8_SA(0, 1), cA + hstepA, voffA);
        if (wr == 1) PG8_BAR;
        PG8_WAIT_V(2); PG8_BAR;
        PG8_STAGE(PG8_SB(1, 0), cB + kstep, voffB); PG8_STAGE(PG8_SA(1, 0), cA + kstep, voffA); PG8_STAGE(PG8_SB(1, 1), cB + hstep + kstep, voffB);
        PG8_WAIT_V(6); PG8_BAR;
    } else {
        PG8_STAGE(PG8_SB(0, 0), cB, voffB); PG8_STAGE(PG8_SA(0, 0), cA, voffA); PG8_STAGE(PG8_SB(0, 1), cB + hstep, voffB); PG8_STAGE(PG8_SA(0, 1), cA + hstepA, voffA);
        if (wr == 1) PG8_BAR;
        PG8_WAIT_V(4); PG8_BAR;
        PG8_STAGE(PG8_SB(1, 0), cB + kstep, voffB); PG8_STAGE(PG8_SA(1, 0), cA + kstep, voffA); PG8_STAGE(PG8_SB(1, 1), cB + hstep + kstep, voffB);
        PG8_WAIT_V(6); PG8_BAR;
    }
    for (;;) {
        const bool has_next = S.next(ui + 1, nxt);
        const char* nA = has_next ? (const char*)g.A + (size_t)nxt.pm * tstepA : cA; const char* nB = has_next ? (const char*)g.Bt + (size_t)nxt.pn * tstep : cB;
        for (int t = 0; t < nt; t += 2) {
            const bool last = (t == nt - 2);
            const char* a1 = cA + (size_t)(t + 1) * kstep;
            const char* a2 = last ? nA : cA + (size_t)(t + 2) * kstep; const char* b2 = last ? nB : cB + (size_t)(t + 2) * kstep;
            const char* a3 = a2 + kstep; const char* b3 = b2 + kstep;
            if (last && has_next) S.a_ready(nxt);
            if constexpr (SP2) {
            PG8_LDB(B0, 0, 0); PG8_LDB(B1, 0, 1); PG8_SCHED; PG8_LDA(At, 0, 0); PG8_STAGE(PG8_SA(1, 1), a1 + hstepA, voffA);
            PG8_WAIT_V(8); PG8_WAIT_L(0); PG8_BAR; PG8_MMA(0, 0, At, B0); PG8_MMA(0, 1, At, B1); PG8_BAR; PG8_SCHED;
            PG8_LDA(At, 0, 1); PG8_STAGE(PG8_SB(0, 0), b2, voffB); PG8_STAGE(PG8_SB(0, 1), b2 + hstep, voffB); PG8_STAGE(PG8_SA(0, 0), a2, voffA);
            PG8_WAIT_V(8); PG8_WAIT_L(0); PG8_BAR; PG8_MMA(1, 0, At, B0); PG8_MMA(1, 1, At, B1); PG8_BAR; PG8_SCHED;
            PG8_LDB(B0, 1, 0); PG8_LDB(B1, 1, 1); PG8_SCHED; PG8_LDA(At, 1, 0); PG8_STAGE(PG8_SA(0, 1), a2 + hstepA, voffA);
            PG8_WAIT_V(8); PG8_WAIT_L(0); PG8_BAR; PG8_MMA(0, 0, At, B0); PG8_MMA(0, 1, At, B1); PG8_BAR; PG8_SCHED;
            PG8_LDA(At, 1, 1); PG8_STAGE(PG8_SB(1, 0), b3, voffB); PG8_STAGE(PG8_SB(1, 1), b3 + hstep, voffB); PG8_STAGE(PG8_SA(1, 0), a3, voffA);
            PG8_WAIT_V(8); PG8_WAIT_L(0); PG8_BAR; PG8_MMA(1, 0, At, B0); PG8_MMA(1, 1, At, B1); PG8_BAR; PG8_SCHED;
            } else {
            PG8_LDB(B0, 0, 0); PG8_SCHED; PG8_LDA(At, 0, 0); PG8_STAGE(PG8_SA(1, 1), a1 + hstepA, voffA);
            PG8_WAIT_L(8); PG8_BAR; PG8_WAIT_L(0); PG8_MMA(0, 0, At, B0); PG8_BAR; PG8_SCHED;
            PG8_LDB(B1, 0, 1); PG8_STAGE(PG8_SB(0, 0), b2, voffB);
            PG8_BAR; PG8_WAIT_L(0); PG8_MMA(0, 1, At, B1); PG8_BAR;
            PG8_LDA(At, 0, 1); PG8_STAGE(PG8_SA(0, 0), a2, voffA);
            PG8_BAR; PG8_WAIT_L(0); PG8_MMA(1, 0, At, B0); PG8_BAR; PG8_SCHED;
            PG8_STAGE(PG8_SB(0, 1), b2 + hstep, voffB);
            PG8_WAIT_V(6); PG8_BAR; PG8_MMA(1, 1, At, B1); PG8_BAR;
            PG8_LDB(B0, 1, 0); PG8_SCHED; PG8_LDA(At, 1, 0); PG8_STAGE(PG8_SA(0, 1), a2 + hstepA, voffA);
            PG8_WAIT_L(8); PG8_BAR; PG8_WAIT_L(0); PG8_MMA(0, 0, At, B0); PG8_BAR; PG8_SCHED;
            PG8_LDB(B1, 1, 1); PG8_STAGE(PG8_SB(1, 0), b3, voffB);
            PG8_BAR; PG8_WAIT_L(0); PG8_MMA(0, 1, At, B1); PG8_BAR;
            PG8_LDA(At, 1, 1); PG8_STAGE(PG8_SA(1, 0), a3, voffA);
            PG8_BAR; PG8_WAIT_L(0); PG8_MMA(1, 0, At, B0); PG8_BAR; PG8_SCHED;
            PG8_STAGE(PG8_SB(1, 1), b3 + hstep, voffB);
            PG8_WAIT_V(6); PG8_BAR; PG8_MMA(1, 1, At, B1); PG8_BAR;
            }
        }
        if constexpr (ALIGN_EPI) { if (wr == 0) PG8_BAR; }
        if constexpr (!Epi::AFTER_DRAIN) { E(acc, cur, wr, wc, fr, fq); S.done(cur); }
        if (!has_next) break;
#pragma unroll
        for (int a = 0; a < 2; ++a)
#pragma unroll
            for (int b = 0; b < 2; ++b)
#pragma unroll
                for (int m = 0; m < 4; ++m)
#pragma unroll
                    for (int n = 0; n < 2; ++n) acc[a][b][m][n] = (f32x4){0.f, 0.f, 0.f, 0.f};
        cur = nxt; cA = nA; cB = nB; ++ui;
        if constexpr (ALIGN_EPI) { if (wr == 1) PG8_BAR; }
    }
    PG8_WAIT_V(0);
    if constexpr (!ALIGN_EPI) { if (wr == 0) PG8_BAR; }
    PG8_BAR;
    if constexpr (Epi::AFTER_DRAIN) { E.fused(acc, cur, wr, wc, fr, fq, lds, wid, lane); S.done(cur); }
#undef PG8_SA
#undef PG8_SB
#undef PG8_STAGE
#undef PG8_LDA
#undef PG8_LDB
#undef PG8_MMA
#undef PG8_WAIT_V
#undef PG8_WAIT_L
#undef PG8_BAR
#undef PG8_SCHED
}

}

namespace pg8 {
struct EpiStore {
    static constexpr bool PERM = true, AFTER_DRAIN = false;
    bf16_t* O; int ldc; int nmain; float* dt;
    __device__ __forceinline__ void operator()(const f32x4 (&acc)[2][2][4][2], const Unit& u, int wr, int wc, int fr, int fq) const {
        const int row0 = u.pm * BM + wr * 64 + fr; const int colt = u.pn * BM;
        if (colt < nmain) {
            const int col0 = colt + wc * 32 + 8 * fq;
#pragma unroll
            for (int ai = 0; ai < 2; ++ai)
#pragma unroll
                for (int m = 0; m < 4; ++m) { bf16_t* rowp = O + (size_t)(row0 + ai * HALF + m * 16) * ldc + col0;
#pragma unroll
                    for (int bj = 0; bj < 2; ++bj) { const f32x4 v0 = acc[ai][bj][m][0], v1 = acc[ai][bj][m][1];
                        u32x4 w; w.x = cvtpk(v0[0], v0[1]); w.y = cvtpk(v0[2], v0[3]); w.z = cvtpk(v1[0], v1[1]); w.w = cvtpk(v1[2], v1[3]);
                        *(u32x4*)(rowp + bj * HALF) = w; } }
        } else if (dt != nullptr && wc == 0) {
#pragma unroll
            for (int ai = 0; ai < 2; ++ai)
#pragma unroll
                for (int m = 0; m < 4; ++m) { float* p = dt + (size_t)(row0 + ai * HALF + m * 16) * 32 + 8 * fq;
                    *(f32x4*)p = acc[ai][0][m][0]; *(f32x4*)(p + 4) = acc[ai][0][m][1]; }
        }
    }
};
}

DI void transpose_item(const float* W, int K, int N, bf16_t* WT, LAS float* scr, int item, int lane, const float* gk, int gmask, float gscale, int nq, float qscale) {
    const int nblk = N / 32, kb = item / nblk, nb = item % nblk, k0 = 64 * kb, n0 = 32 * nb;
#pragma unroll 8
    for (int i = 0; i < 32; ++i) { const int kk = 2 * i + (lane >> 5); const float g = gk ? gk[(k0 + kk) & gmask] * gscale : 1.0f;
        scr[kk * 33 + (lane & 31)] = W[(size_t)(k0 + kk) * N + n0 + (lane & 31)] * g; }
    LDS_WAIT(); asm volatile("" ::: "memory");
    const int c = lane & 7;
#pragma unroll
    for (int j = 0; j < 4; ++j) { const int n = (lane >> 3) + 8 * j; const LAS float* s = scr + (8 * c) * 33 + n; const float cs = (n0 + n < nq) ? qscale : 1.0f;
        u32x4 o; o.x = cvtpk(s[0 * 33] * cs, s[1 * 33] * cs); o.y = cvtpk(s[2 * 33] * cs, s[3 * 33] * cs); o.z = cvtpk(s[4 * 33] * cs, s[5 * 33] * cs); o.w = cvtpk(s[6 * 33] * cs, s[7 * 33] * cs);
        *(u32x4*)(WT + (size_t)(n0 + n) * K + k0 + 8 * c) = o; }
    LDS_WAIT(); asm volatile("" ::: "memory");
}

struct Ctx {
    float* out; unsigned char* ws;
    LAS unsigned char* lds;
    int tid, lane, wid, gw, ngw, bid;
};
constexpr int PTR_OFF = LDS_BYTES - 256;
DI const float* inp(const Ctx& c, int k) {
    const unsigned long long v = ((const LAS unsigned long long*)(c.lds + PTR_OFF))[k];
    const unsigned lo = __builtin_amdgcn_readfirstlane((unsigned)v), hi = __builtin_amdgcn_readfirstlane((unsigned)(v >> 32));
    return (const float*)(((unsigned long long)hi << 32) | lo);
}
DI float lambda_init(int i) { return (i == 1) ? 0.35550906759096926f : 0.5560582041556405f; }

DI void convert_phase(const Ctx& c, int kind, int i) {
    LAS float* scr = (LAS float*)(c.lds + c.wid * 8448);
    bf16_t* W1 = (bf16_t*)(c.ws + WS_W1); bf16_t* W2 = (bf16_t*)(c.ws + WS_W2);
    const int j = i >> 1;
    const float* WA; const float* WB; int KA = DM, NA, KB, NB_ = DM; const float* gA; const float* gB = nullptr; int maskB = 0; float gsB = 1.0f; int nq = 0; float qs = 1.0f;
    if (kind == 0) { WA = inp(c, 1) + (size_t)j * DM * NIN; NA = NIN; gA = inp(c, 16) + i * DM; WB = inp(c, 8) + (size_t)j * DIN * DM; KB = DIN; gB = inp(c, 7) + j * DIN; maskB = DIN - 1; }
    else if (kind == 1) { WA = inp(c, 9) + (size_t)j * DM * NQKV; NA = NQKV; gA = inp(c, 16) + i * DM; nq = DM; qs = 0.125f * LOG2E;
                          WB = inp(c, 15) + (size_t)j * DM * DM; KB = DM; gB = inp(c, 14) + j * 128; maskB = 127; gsB = 1.0f - lambda_init(i); }
    else { WA = inp(c, 20) + (size_t)i * DM * NUP; NA = NUP; gA = inp(c, 18) + i * DM; WB = inp(c, 23) + (size_t)i * DFF * DM; KB = DFF; }
    const int nA = (KA / 64) * (NA / 32), nB = (KB / 64) * (NB_ / 32);
    for (int it = c.gw; it < nA + nB; it += c.ngw) {
        if (it < nA) transpose_item(WA, KA, NA, W1, scr, it, c.lane, gA, DM - 1, 1.0f, nq, qs);
        else transpose_item(WB, KB, NB_, W2, scr, it - nA, c.lane, gB, maskB, gsB, 0, 1.0f);
    }
    if (kind == 0) {
        u32x4* z = (u32x4*)(W1 + (size_t)NIN * DM); const int n16 = (NINP - NIN) * DM / 8;
        for (int t = c.gw * 64 + c.lane; t < n16; t += c.ngw * 64) z[t] = (u32x4){0u, 0u, 0u, 0u};
    }
}

DI void rowwise_phase(const Ctx& c, const float* xin, const bf16_t* Mb, const float* gpost, float* xres, bf16_t* XN, bool last) {
    for (int row = c.gw; row < MROWS; row += c.ngw) {
        f32x4 v[4];
        if (xin) {
#pragma unroll
            for (int j = 0; j < 4; ++j) v[j] = *(const f32x4*)(xin + (size_t)row * DM + 4 * c.lane + 256 * j);
        } else {
            f32x4 mv[4]; float ss = 0.f;
#pragma unroll
            for (int j = 0; j < 4; ++j) { const u32x2 w = *(const u32x2*)(Mb + (size_t)row * DM + 4 * c.lane + 256 * j);
                mv[j] = (f32x4){bflo(w.x), bfhi(w.x), bflo(w.y), bfhi(w.y)}; ss += (mv[j].x * mv[j].x + mv[j].y * mv[j].y) + (mv[j].z * mv[j].z + mv[j].w * mv[j].w); }
            const float rm = rsqrtf(wave_sum(ss) * (1.0f / DM) + EPS);
#pragma unroll
            for (int j = 0; j < 4; ++j) { const f32x4 x = *(const f32x4*)(xres + (size_t)row * DM + 4 * c.lane + 256 * j); const f32x4 g = *(const f32x4*)(gpost + 4 * c.lane + 256 * j);
                v[j] = x + mv[j] * rm * g; }
        }
#pragma unroll
        for (int j = 0; j < 4; ++j) *(f32x4*)(xres + (size_t)row * DM + 4 * c.lane + 256 * j) = v[j];
        if (!last) {
            float s2 = 0.f;
#pragma unroll
            for (int j = 0; j < 4; ++j) s2 += (v[j].x * v[j].x + v[j].y * v[j].y) + (v[j].z * v[j].z + v[j].w * v[j].w);
            const float rs = rsqrtf(wave_sum(s2) * (1.0f / DM) + EPS);
#pragma unroll
            for (int j = 0; j < 4; ++j) { u32x2 o; o.x = cvtpk(v[j].x * rs, v[j].y * rs); o.y = cvtpk(v[j].z * rs, v[j].w * rs); *(u32x2*)(XN + (size_t)row * DM + 4 * c.lane + 256 * j) = o; }
        }
    }
}

DI void ffn_gate_phase(const Ctx& c, int i) {
    const bf16_t* H = (const bf16_t*)(c.ws + WS_BIG); bf16_t* ACT = (bf16_t*)(c.ws + WS_ACT);
    const float* cw = inp(c, 21) + (size_t)i * 3 * NUP; const float* cb = inp(c, 22) + (size_t)i * NUP;
    constexpr int NCH = DFF / 8, RUN = 16, NRUN = MROWS / RUN;
    const int gt = c.bid * 512 + c.tid, ngt = gridDim.x * 512;
    for (int u = gt; u < NCH * NRUN; u += ngt) {
        const int ch = u % NCH, run = u / NCH, col = ch * 8, row0 = run * RUN;
        float wg[3][8], wu[3][8], bg[8], bu[8];
#pragma unroll
        for (int k = 0; k < 3; ++k) {
            const f32x4 a0 = *(const f32x4*)(cw + k * NUP + col), a1 = *(const f32x4*)(cw + k * NUP + col + 4);
            const f32x4 b0 = *(const f32x4*)(cw + k * NUP + DFF + col), b1 = *(const f32x4*)(cw + k * NUP + DFF + col + 4);
#pragma unroll
            for (int e = 0; e < 4; ++e) { wg[k][e] = a0[e]; wg[k][4 + e] = a1[e]; wu[k][e] = b0[e]; wu[k][4 + e] = b1[e]; }
        }
        { const f32x4 a0 = *(const f32x4*)(cb + col), a1 = *(const f32x4*)(cb + col + 4), b0 = *(const f32x4*)(cb + DFF + col), b1 = *(const f32x4*)(cb + DFF + col + 4);
#pragma unroll
          for (int e = 0; e < 4; ++e) { bg[e] = a0[e]; bg[4 + e] = a1[e]; bu[e] = b0[e]; bu[4 + e] = b1[e]; } }
        float g2[8], g1[8], u2[8], u1[8];
        if ((row0 & (SEQ - 1)) == 0) {
#pragma unroll
            for (int e = 0; e < 8; ++e) { g2[e] = 0.f; g1[e] = 0.f; u2[e] = 0.f; u1[e] = 0.f; }
        } else {
            const u32x4 a = *(const u32x4*)(H + (size_t)(row0 - 2) * NUP + col), b = *(const u32x4*)(H + (size_t)(row0 - 1) * NUP + col);
            const u32x4 p = *(const u32x4*)(H + (size_t)(row0 - 2) * NUP + DFF + col), q = *(const u32x4*)(H + (size_t)(row0 - 1) * NUP + DFF + col);
#pragma unroll
            for (int e = 0; e < 4; ++e) { g2[2 * e] = bflo(a[e]); g2[2 * e + 1] = bfhi(a[e]); g1[2 * e] = bflo(b[e]); g1[2 * e + 1] = bfhi(b[e]);
                                          u2[2 * e] = bflo(p[e]); u2[2 * e + 1] = bfhi(p[e]); u1[2 * e] = bflo(q[e]); u1[2 * e + 1] = bfhi(q[e]); }
        }
#pragma unroll 4
        for (int r = 0; r < RUN; ++r) {
            const u32x4 a = *(const u32x4*)(H + (size_t)(row0 + r) * NUP + col), p = *(const u32x4*)(H + (size_t)(row0 + r) * NUP + DFF + col);
            float g0[8], u0[8], o[8];
#pragma unroll
            for (int e = 0; e < 4; ++e) { g0[2 * e] = bflo(a[e]); g0[2 * e + 1] = bfhi(a[e]); u0[2 * e] = bflo(p[e]); u0[2 * e + 1] = bfhi(p[e]); }
#pragma unroll
            for (int e = 0; e < 8; ++e) { const float yg = bg[e] + wg[0][e] * g2[e] + wg[1][e] * g1[e] + wg[2][e] * g0[e]; const float yu = bu[e] + wu[0][e] * u2[e] + wu[1][e] * u1[e] + wu[2][e] * u0[e];
                o[e] = silu_f(yg) * yu; g2[e] = g1[e]; g1[e] = g0[e]; u2[e] = u1[e]; u1[e] = u0[e]; }
            u32x4 w; w.x = cvtpk(o[0], o[1]); w.y = cvtpk(o[2], o[3]); w.z = cvtpk(o[4], o[5]); w.w = cvtpk(o[6], o[7]);
            *(u32x4*)(ACT + (size_t)(row0 + r) * DFF + col) = w;
        }
    }
}

DI void ssm_conv8(const bf16_t* proj, int row, int t, int ch, const float (&w)[4][8], const float (&b)[8], float (&o)[8]) {
#pragma unroll
    for (int e = 0; e < 8; ++e) o[e] = b[e];
#pragma unroll
    for (int k = 0; k < 4; ++k) {
        if (t - 3 + k >= 0) {
            const u32x4 v = *(const u32x4*)(proj + (size_t)(row - 3 + k) * NPROJ + DIN + ch);
#pragma unroll
            for (int e = 0; e < 4; ++e) { o[2 * e] += w[k][2 * e] * bflo(v[e]); o[2 * e + 1] += w[k][2 * e + 1] * bfhi(v[e]); }
        }
    }
#pragma unroll
    for (int e = 0; e < 8; ++e) o[e] = silu_f(o[e]);
}
DI void ssm_conv_w8(const float* cw, const float* cb, int ch, float (&w)[4][8], float (&b)[8]) {
#pragma unroll
    for (int k = 0; k < 4; ++k) { const f32x4 a0 = *(const f32x4*)(cw + k * XBC + ch), a1 = *(const f32x4*)(cw + k * XBC + ch + 4);
#pragma unroll
        for (int e = 0; e < 4; ++e) { w[k][e] = a0[e]; w[k][4 + e] = a1[e]; } }
    const f32x4 a0 = *(const f32x4*)(cb + ch), a1 = *(const f32x4*)(cb + ch + 4);
#pragma unroll
    for (int e = 0; e < 4; ++e) { b[e] = a0[e]; b[4 + e] = a1[e]; }
}
DI void ssd_dt_prep(const Ctx& c, int j, int row0, int g, LAS float* dtv, LAS float* acs, LAS float* tot) {
    const float* DT = (const float*)(c.ws + WS_DT);
    const int h = c.tid >> 7, l = c.tid & 127, head = g * 4 + h;
    const float raw = DT[(size_t)(row0 + l) * 32 + head] + inp(c, 4)[j * 32 + head];
    const float dt = raw > 20.0f ? raw : log1pf(__expf(raw));
    const float A = -__expf(inp(c, 5)[j * 32 + head]);
    float s = dt * A;
#pragma unroll
    for (int o = 1; o < 64; o <<= 1) { const float n = __shfl_up(s, o); if (c.lane >= o) s += n; }
    if (c.lane == 63) tot[c.wid] = s;
    dtv[h * 128 + l] = dt;
    __syncthreads();
    if (c.wid & 1) s += tot[c.wid - 1];
    acs[h * 128 + l] = s;
    __syncthreads();
}

DI void ssd_states_phase(const Ctx& c, int j) {
    const bf16_t* proj = (const bf16_t*)(c.ws + WS_BIG); bf16_t* ST = (bf16_t*)(c.ws + WS_ST); float* CD = (float*)(c.ws + WS_CD);
    const float* cw = inp(c, 2) + (size_t)j * 4 * XBC; const float* cb = inp(c, 3) + (size_t)j * XBC;
    LAS bf16_t* XT = (LAS bf16_t*)c.lds;
    LAS bf16_t* BT = XT + 256 * 136;
    LAS float* dtv = (LAS float*)(BT + 128 * 136);
    LAS float* acs = dtv + 512; LAS float* wgt = acs + 512; LAS float* tot = wgt + 512;
    const int r = c.lane & 31, hh = c.lane >> 5;
    for (int item = c.bid; item < 1024; item += gridDim.x) {
        const int b = item >> 8, ci = (item >> 3) & 31, g = item & 7, row0 = b * SEQ + ci * 128, t0 = ci * 128;
        ssd_dt_prep(c, j, row0, g, dtv, acs, tot);
        { const int h = c.tid >> 7, l = c.tid & 127; const float last = acs[h * 128 + 127], s = acs[h * 128 + l];
          wgt[h * 128 + l] = dtv[h * 128 + l] * __expf(last - s);
          if (l == 127) CD[(b * 32 + ci) * 32 + g * 4 + h] = __expf(s); }
        __syncthreads();
        {
            const int chunk = c.tid & 31, ch = g * 256 + chunk * 8, h = chunk >> 3; float w[4][8], bb[8]; ssm_conv_w8(cw, cb, ch, w, bb);
#pragma unroll 2
            for (int it = 0; it < 8; ++it) { const int l = (c.tid >> 5) + 16 * it; float o[8]; ssm_conv8(proj, row0 + l, t0 + l, ch, w, bb, o); const float sc = wgt[h * 128 + l];
#pragma unroll
                for (int e = 0; e < 8; ++e) XT[(chunk * 8 + e) * 136 + l] = (bf16_t)(cvtpk(o[e] * sc, 0.f) & 0xffffu); }
        }
        {
            const int chunk = c.tid & 15, ch = DIN + g * 128 + chunk * 8; float w[4][8], bb[8]; ssm_conv_w8(cw, cb, ch, w, bb);
#pragma unroll 2
            for (int it = 0; it < 4; ++it) { const int l = (c.tid >> 4) + 32 * it; float o[8]; ssm_conv8(proj, row0 + l, t0 + l, ch, w, bb, o);
#pragma unroll
                for (int e = 0; e < 8; ++e) BT[(chunk * 8 + e) * 136 + l] = (bf16_t)(cvtpk(o[e], 0.f) & 0xffffu); }
        }
        __syncthreads();
        {
            const int h = c.wid >> 1, pt = c.wid & 1; f32x16 acc[4];
#pragma unroll
            for (int nt = 0; nt < 4; ++nt)
#pragma unroll
                for (int e = 0; e < 16; ++e) acc[nt][e] = 0.f;
#pragma unroll
            for (int ks = 0; ks < 8; ++ks) { const bf16x8 bop = *(const LAS bf16x8*)(XT + (h * 64 + pt * 32 + r) * 136 + 16 * ks + 8 * hh);
#pragma unroll
                for (int nt = 0; nt < 4; ++nt) { const bf16x8 a = *(const LAS bf16x8*)(BT + (nt * 32 + r) * 136 + 16 * ks + 8 * hh); acc[nt] = MFMA32(a, bop, acc[nt]); } }
            bf16_t* dst = ST + ((size_t)((b * 32 + ci) * 32 + g * 4 + h) * 64 + pt * 32 + r) * 128;
#pragma unroll
            for (int nt = 0; nt < 4; ++nt)
#pragma unroll
                for (int q = 0; q < 4; ++q) { u32x2 o; o.x = cvtpk(acc[nt][4 * q], acc[nt][4 * q + 1]); o.y = cvtpk(acc[nt][4 * q + 2], acc[nt][4 * q + 3]); *(u32x2*)(dst + nt * 32 + 8 * q + 4 * hh) = o; }
        }
        __syncthreads();
    }
}

DI void ssd_scan_phase(const Ctx& c) {
    bf16_t* ST = (bf16_t*)(c.ws + WS_ST); const float* CD = (const float*)(c.ws + WS_CD);
    for (int idx = c.bid * 512 + c.tid; idx < 4 * 32 * 1024; idx += gridDim.x * 512) {
        const int e8 = idx & 1023, head = (idx >> 10) & 31, b = idx >> 15; float carry[8];
#pragma unroll
        for (int e = 0; e < 8; ++e) carry[e] = 0.f;
#pragma unroll 4
        for (int ci = 0; ci < 32; ++ci) { u32x4* p = (u32x4*)(ST + ((size_t)((b * 32 + ci) * 32 + head) * 8192 + e8 * 8)); const u32x4 s = *p; const float dec = CD[(b * 32 + ci) * 32 + head];
            u32x4 o; o.x = cvtpk(carry[0], carry[1]); o.y = cvtpk(carry[2], carry[3]); o.z = cvtpk(carry[4], carry[5]); o.w = cvtpk(carry[6], carry[7]); *p = o;
#pragma unroll
            for (int e = 0; e < 4; ++e) { carry[2 * e] = carry[2 * e] * dec + bflo(s[e]); carry[2 * e + 1] = carry[2 * e + 1] * dec + bfhi(s[e]); } }
    }
}

DI void ssd_out_phase(const Ctx& c, int j) {
    const bf16_t* proj = (const bf16_t*)(c.ws + WS_BIG); const bf16_t* ST = (const bf16_t*)(c.ws + WS_ST); bf16_t* Y = (bf16_t*)(c.ws + WS_Y);
    const float* cw = inp(c, 2) + (size_t)j * 4 * XBC; const float* cb = inp(c, 3) + (size_t)j * XBC;
    LAS bf16_t* Cn = (LAS bf16_t*)c.lds;
    LAS bf16_t* Bn = Cn + 128 * 136;
    LAS bf16_t* XTh = Bn + 128 * 136; LAS bf16_t* PV = XTh + 64 * 136;
    LAS float* dtv = (LAS float*)(PV + 64 * 136);
    LAS float* acs = dtv + 512; LAS float* tot = acs + 512; LAS float* red = tot + 8;
    const int r = c.lane & 31, hh = c.lane >> 5, lb = c.wid & 3, ph = c.wid >> 2;
    for (int item = c.bid; item < 1024; item += gridDim.x) {
        const int b = item >> 8, ci = (item >> 3) & 31, g = item & 7, row0 = b * SEQ + ci * 128, t0 = ci * 128;
        ssd_dt_prep(c, j, row0, g, dtv, acs, tot);
        {
            const int chunk = c.tid & 15;
            { const int ch = DIN + g * 128 + chunk * 8; float w[4][8], bb[8]; ssm_conv_w8(cw, cb, ch, w, bb);
#pragma unroll 2
              for (int it = 0; it < 4; ++it) { const int l = (c.tid >> 4) + 32 * it; float o[8]; ssm_conv8(proj, row0 + l, t0 + l, ch, w, bb, o);
                  u32x4 v; v.x = cvtpk(o[0], o[1]); v.y = cvtpk(o[2], o[3]); v.z = cvtpk(o[4], o[5]); v.w = cvtpk(o[6], o[7]); *(LAS u32x4*)(Bn + l * 136 + chunk * 8) = v; } }
            { const int ch = DIN + 1024 + g * 128 + chunk * 8; float w[4][8], bb[8]; ssm_conv_w8(cw, cb, ch, w, bb);
#pragma unroll 2
              for (int it = 0; it < 4; ++it) { const int l = (c.tid >> 4) + 32 * it; float o[8]; ssm_conv8(proj, row0 + l, t0 + l, ch, w, bb, o);
                  u32x4 v; v.x = cvtpk(o[0], o[1]); v.y = cvtpk(o[2], o[3]); v.z = cvtpk(o[4], o[5]); v.w = cvtpk(o[6], o[7]); *(LAS u32x4*)(Cn + l * 136 + chunk * 8) = v; } }
        }
        const int l = lb * 32 + r;
        float ssq = 0.f;
#pragma unroll 1
        for (int h = 0; h < 4; ++h) {
            const int head = g * 4 + h;
            {
                const int chunk = c.tid & 7, ch = g * 256 + h * 64 + chunk * 8; float w[4][8], bb[8]; ssm_conv_w8(cw, cb, ch, w, bb);
#pragma unroll
                for (int it = 0; it < 2; ++it) { const int ll = (c.tid >> 3) + 64 * it; float o[8]; ssm_conv8(proj, row0 + ll, t0 + ll, ch, w, bb, o);
#pragma unroll
                    for (int e = 0; e < 8; ++e) XTh[(chunk * 8 + e) * 136 + ll] = (bf16_t)(cvtpk(o[e], 0.f) & 0xffffu); }
                const bf16_t* src = ST + (size_t)((b * 32 + ci) * 32 + head) * 8192;
#pragma unroll
                for (int it = 0; it < 2; ++it) { const int idx = c.tid + 512 * it, p = idx >> 4, n8 = idx & 15; *(LAS u32x4*)(PV + p * 136 + n8 * 8) = *(const u32x4*)(src + p * 128 + n8 * 8); }
            }
            __syncthreads();
            f32x16 acc;
#pragma unroll
            for (int e = 0; e < 16; ++e) acc[e] = 0.f;
#pragma unroll
            for (int ks = 0; ks < 8; ++ks) { const bf16x8 a = *(const LAS bf16x8*)(PV + (ph * 32 + r) * 136 + 16 * ks + 8 * hh); const bf16x8 bop = *(const LAS bf16x8*)(Cn + (lb * 32 + r) * 136 + 16 * ks + 8 * hh);
                acc = MFMA32(a, bop, acc); }
            const float al = acs[h * 128 + l]; const float eal = __expf(al);
#pragma unroll
            for (int e = 0; e < 16; ++e) acc[e] *= eal;
#pragma unroll
            for (int sb = 0; sb < 4; ++sb) {
                if (sb <= lb) {
                    f32x16 cbt;
#pragma unroll
                    for (int e = 0; e < 16; ++e) cbt[e] = 0.f;
#pragma unroll
                    for (int ks = 0; ks < 8; ++ks) { const bf16x8 a = *(const LAS bf16x8*)(Bn + (sb * 32 + r) * 136 + 16 * ks + 8 * hh); const bf16x8 bop = *(const LAS bf16x8*)(Cn + (lb * 32 + r) * 136 + 16 * ks + 8 * hh);
                        cbt = MFMA32(a, bop, cbt); }
#pragma unroll
                    for (int ss = 0; ss < 2; ++ss) {
                        float v[8];
#pragma unroll
                        for (int jj = 0; jj < 8; ++jj) { const int i = 8 * ss + jj, s = sb * 32 + crow(i, hh); const float e = (s <= l) ? __expf(al - acs[h * 128 + s]) * dtv[h * 128 + s] : 0.f; v[jj] = cbt[i] * e; }
                        u32x4 pk; pk.x = cvtpk(v[0], v[1]); pk.y = cvtpk(v[2], v[3]); pk.z = cvtpk(v[4], v[5]); pk.w = cvtpk(v[6], v[7]);
                        const bf16x8 bop = __builtin_bit_cast(bf16x8, pk);
                        const LAS bf16_t* ap = XTh + (ph * 32 + r) * 136 + sb * 32 + 16 * ss + 4 * hh;
                        const s16x4 lo = *(const LAS s16x4*)ap, hi = *(const LAS s16x4*)(ap + 8);
                        const bf16x8 a = __builtin_shufflevector(lo, hi, 0, 1, 2, 3, 4, 5, 6, 7);
                        acc = MFMA32(a, bop, acc);
                    }
                }
            }
            const float Dh = inp(c, 6)[j * 32 + head];
#pragma unroll
            for (int q = 0; q < 4; ++q) {
                const int p4 = ph * 32 + 8 * q + 4 * hh;
                const u32x2 zz = *(const u32x2*)(proj + (size_t)(row0 + l) * NPROJ + g * 256 + h * 64 + p4);
                const float zf[4] = {bflo(zz.x), bfhi(zz.x), bflo(zz.y), bfhi(zz.y)}; float yv[4];
#pragma unroll
                for (int e = 0; e < 4; ++e) { const float xs = bf1(XTh[(p4 + e) * 136 + l]); yv[e] = (acc[4 * q + e] + Dh * xs) * silu_f(zf[e]); }
                u32x2 o; o.x = cvtpk(yv[0], yv[1]); o.y = cvtpk(yv[2], yv[3]);
                { const float a0 = bflo(o.x), a1 = bfhi(o.x), a2 = bflo(o.y), a3 = bfhi(o.y); ssq += (a0 * a0 + a1 * a1) + (a2 * a2 + a3 * a3); }
                *(u32x2*)(Y + (size_t)(row0 + l) * DIN + g * 256 + h * 64 + p4) = o;
            }
            __syncthreads();
        }
        ssq += __shfl_xor(ssq, 32);
        if (hh == 0) red[c.wid * 32 + r] = ssq;
        __syncthreads();
        const float rstd = rsqrtf((red[lb * 32 + r] + red[(lb + 4) * 32 + r]) * (1.0f / 256.0f) + EPS);
#pragma unroll 1
        for (int h = 0; h < 4; ++h)
#pragma unroll
            for (int q = 0; q < 4; ++q) { u32x2* yp = (u32x2*)(Y + (size_t)(row0 + l) * DIN + g * 256 + h * 64 + ph * 32 + 8 * q + 4 * hh); const u32x2 w = *yp;
                u32x2 o; o.x = cvtpk(bflo(w.x) * rstd, bfhi(w.x) * rstd); o.y = cvtpk(bflo(w.y) * rstd, bfhi(w.y) * rstd); *yp = o; }
        __syncthreads();
    }
}

DI void attn_load_tile(const bf16_t* QKV, int b, int h, int t, int kt, int tid, u32x4& kreg, u32x4 (&vreg)[2]) {
    const bf16_t* tb = QKV + (size_t)(b * SEQ + kt * 64) * NQKV + h * 128;
    const unsigned koff = (unsigned)((tid >> 3) * NQKV + DM + 8 * (tid & 7)), voff = (unsigned)((tid >> 4) * 2 * NQKV + 2 * DM + 8 * (tid & 15));
    kreg = *(const u32x4*)(tb + t * 64 + koff);
#pragma unroll
    for (int kk = 0; kk < 2; ++kk) vreg[kk] = *(const u32x4*)(tb + voff + kk * NQKV);
}
DI void attn_store_tile(LAS bf16_t* Kn, LAS bf16_t* Vt, int tid, const u32x4& kreg, const u32x4 (&vreg)[2]) {
    *(LAS u32x4*)(Kn + (tid >> 3) * 72 + 8 * (tid & 7)) = kreg;
    const int e8 = tid & 15, kp = tid >> 4, kq = kp >> 1;
    const int gidx = ((kq & 0xC) >> 1) + (kq & 1), sw = gidx ^ (e8 & 7), off = (sw << 3) + ((kq & 2) << 1) + 2 * (kp & 1);
#pragma unroll
    for (int cc = 0; cc < 8; ++cc) { const int wd = cc >> 1; const unsigned a0 = vreg[0][wd], a1 = vreg[1][wd];
        const unsigned o = (cc & 1) ? ((a0 >> 16) | (a1 & 0xffff0000u)) : ((a0 & 0xffffu) | (a1 << 16));
        *(LAS unsigned*)(Vt + (8 * e8 + cc) * 72 + off) = o; }
}
DI void attn_phase(const Ctx& c, int i) {
    const int j = i >> 1;
    const bf16_t* QKV = (const bf16_t*)(c.ws + WS_BIG); bf16_t* AO = (bf16_t*)(c.ws + WS_Y);
    LAS bf16_t* KV0 = (LAS bf16_t*)c.lds;
#define KNB(bb) (KV0 + (bb) * 13824)
#define VTB(bb) (KV0 + (bb) * 13824 + 64 * 72)
    const int r = c.lane & 31, hh = c.lane >> 5;
    for (int up = c.bid; up < 256; up += gridDim.x) {
        const int bh = up >> 3, qsel = up & 7, b = bh >> 3, h = bh & 7;
        const float c2 = exp2f(-(float)(h + 1)) * LOG2E;
#pragma unroll 1
        for (int which = 0; which < 2; ++which) {
            const int qb = which ? qsel : 15 - qsel, q0w = qb * 256 + c.wid * 32, qpos = q0w + r, ntile = 4 * (qb + 1);
            const bf16_t* qbase = QKV + (size_t)(b * SEQ + q0w) * NQKV + h * 128;
            bf16_t* obase = AO + (size_t)(b * SEQ + q0w) * DM + h * 128;
            float* O1S = (float*)(c.ws + WS_BIG + 96 * MiB) + (size_t)(((bh * 16 + qb) * 8 + c.wid) * 16) * 256;

#pragma unroll 1
            for (int t = 0; t < 2; ++t) {
                LAS bf16x8* Qs0 = (LAS bf16x8*)(KV0 + 2 * 13824) + c.wid * 256;
                { int tq = c.tid; asm volatile("" : "+v"(tq)); const unsigned qoff = (unsigned)((tq & 31) * NQKV + 8 * ((tq >> 5) & 1));
#pragma unroll
                  for (int ks = 0; ks < 4; ++ks) Qs0[ks * 64 + (tq & 63)] = *(const bf16x8*)(qbase + t * 64 + 16 * ks + qoff); }
                f32x16 O[4];
#pragma unroll
                for (int et = 0; et < 4; ++et)
#pragma unroll
                    for (int e = 0; e < 16; ++e) O[et][e] = 0.f;
                float m = -1e30f, lsum = 0.f;
                u32x4 kreg, vreg[2];
                attn_load_tile(QKV, b, h, t, 0, c.tid, kreg, vreg);
                attn_store_tile(KNB(0), VTB(0), c.tid, kreg, vreg);
                __syncthreads();
#pragma unroll 1
                for (int kt = 0; kt < ntile; ++kt) {
                    const LAS bf16_t* Kn = KNB(kt & 1); const LAS bf16_t* Vt = VTB(kt & 1);
                    int tidv = c.tid; asm volatile("" : "+v"(tidv));
                    const int r = tidv & 31, hh = (tidv >> 5) & 1;
                    if (kt + 1 < ntile) attn_load_tile(QKV, b, h, t, kt + 1, tidv, kreg, vreg);
                    const int kv0 = kt * 64;
                    if (kv0 <= q0w + 31) {
#pragma unroll 1
                        for (int kb = 0; kb < 2; ++kb) {
                            const int kvb = kv0 + kb * 32;
                            if (kvb > q0w + 31) break;
                            f32x16 st;
#pragma unroll
                            for (int e = 0; e < 16; ++e) st[e] = 0.f;
#pragma unroll
                            for (int ks = 0; ks < 4; ++ks) { const bf16x8 a = *(const LAS bf16x8*)(Kn + (kb * 32 + r) * 72 + 16 * ks + 8 * hh); st = MFMA32(a, Qs0[ks * 64 + (tidv & 63)], st); }
                            const float fb = (float)(kvb + 4 * hh - qpos);
#pragma unroll
                            for (int e = 0; e < 16; ++e) st[e] = fmaf(c2, fb + (float)(8 * (e >> 2) + (e & 3)), st[e]);
                            if (kvb + 31 > q0w) {
#pragma unroll
                                for (int e = 0; e < 16; ++e) { const int kpos = kvb + crow(e, hh); if (kpos > qpos) st[e] = -INFINITY; }
                            }
                            float mx = st[0];
#pragma unroll
                            for (int e = 1; e < 16; ++e) mx = fmaxf(mx, st[e]);
                            mx = fmaxf(mx, __shfl_xor(mx, 32));
                            const float mn = fmaxf(m, mx), alpha = __builtin_amdgcn_exp2f(m - mn); m = mn;
                            float ps = 0.f;
#pragma unroll
                            for (int e = 0; e < 16; ++e) { const float p = __builtin_amdgcn_exp2f(st[e] - mn); st[e] = p; ps += p; }
                            lsum = lsum * alpha + ps;
#pragma unroll
                            for (int et = 0; et < 4; ++et)
#pragma unroll
                                for (int e = 0; e < 16; ++e) O[et][e] *= alpha;
#pragma unroll
                            for (int ss = 0; ss < 2; ++ss) {
                                u32x4 pk; pk.x = cvtpk(st[8 * ss], st[8 * ss + 1]); pk.y = cvtpk(st[8 * ss + 2], st[8 * ss + 3]); pk.z = cvtpk(st[8 * ss + 4], st[8 * ss + 5]); pk.w = cvtpk(st[8 * ss + 6], st[8 * ss + 7]);
                                const bf16x8 bop = __builtin_bit_cast(bf16x8, pk);
#pragma unroll
                                for (int et = 0; et < 4; ++et) { const int e = et * 32 + r; const bf16x8 a = *(const LAS bf16x8*)(Vt + e * 72 + (((kb * 4 + 2 * ss + hh) ^ ((e >> 3) & 7)) << 3)); O[et] = MFMA32(a, bop, O[et]); }
                            }
                        }
                    }
                    if (kt + 1 < ntile) attn_store_tile(KNB((kt + 1) & 1), VTB((kt + 1) & 1), tidv, kreg, vreg);
                    __syncthreads();
                }
                lsum += __shfl_xor(lsum, 32);
                const float inv = 1.0f / lsum;
                int te = c.tid; asm volatile("" : "+v"(te));
                const unsigned o1off = (unsigned)(te & 63) * 4u, aoff = (unsigned)((te & 31) * DM + 4 * ((te >> 5) & 1));
                if (t == 0) {
#pragma unroll
                    for (int et = 0; et < 4; ++et)
#pragma unroll
                        for (int q = 0; q < 4; ++q) { *(f32x4*)(O1S + (et * 4 + q) * 256 + o1off) = (f32x4){O[et][4 * q] * inv, O[et][4 * q + 1] * inv, O[et][4 * q + 2] * inv, O[et][4 * q + 3] * inv}; asm volatile("" ::: "memory"); }
                } else {
                    float s1 = 0.f, s2 = 0.f;
                    { const float* lq1 = inp(c, 10) + j * 64; const float* lk1 = inp(c, 11) + j * 64; const float* lq2 = inp(c, 12) + j * 64; const float* lk2 = inp(c, 13) + j * 64;
#pragma unroll 4
                      for (int d = 0; d < 64; ++d) { s1 += lq1[d] * lk1[d]; s2 += lq2[d] * lk2[d]; } }
                    const float lam = __expf(s1) - __expf(s2) + lambda_init(i);
                    float ssq = 0.f; const float li = lam * inv;
#pragma unroll
                    for (int et = 0; et < 4; ++et)
#pragma unroll
                        for (int q = 0; q < 4; ++q) { const f32x4 o1 = *(const f32x4*)(O1S + (et * 4 + q) * 256 + o1off);
#pragma unroll
                            for (int e = 0; e < 4; ++e) { const float v = o1[e] - li * O[et][4 * q + e]; O[et][4 * q + e] = v; ssq += v * v; } asm volatile("" ::: "memory"); }
                    ssq += __shfl_xor(ssq, 32);
                    const float rstd = rsqrtf(ssq * (1.0f / 128.0f) + EPS);
#pragma unroll
                    for (int et = 0; et < 4; ++et)
#pragma unroll
                        for (int q = 0; q < 4; ++q) { u32x2 o; o.x = cvtpk(O[et][4 * q] * rstd, O[et][4 * q + 1] * rstd); o.y = cvtpk(O[et][4 * q + 2] * rstd, O[et][4 * q + 3] * rstd);
                            *(u32x2*)(obase + et * 32 + 8 * q + aoff) = o; asm volatile("" ::: "memory"); }
                }
            }
        }
    }
}

#ifndef PMASK
#define PMASK 0xff
#endif
struct Args { const float* in[24]; float* out; unsigned char* ws; };
__global__ void __launch_bounds__(512, 2) hybrid_fwd(Args a) {
    extern __shared__ __attribute__((aligned(16))) unsigned char lds_raw[];
    cg::grid_group grid = cg::this_grid();
    Ctx c;
    c.out = a.out; c.ws = a.ws; c.lds = (LAS unsigned char*)lds_raw;
    if (threadIdx.x == 0) {
#pragma unroll
        for (int k = 0; k < 24; ++k) ((LAS unsigned long long*)(c.lds + PTR_OFF))[k] = (unsigned long long)a.in[k];
    }
    __syncthreads();
    c.ngw = gridDim.x * 8;
#define REFRESH() do { int t_ = threadIdx.x; asm volatile("" : "+v"(t_)); int b_ = blockIdx.x; asm volatile("" : "+s"(b_)); c.tid = t_; c.lane = t_ & 63; \
        c.wid = __builtin_amdgcn_readfirstlane(t_ >> 6); c.bid = b_; c.gw = b_ * 8 + c.wid; } while (0)
    REFRESH();
    bf16_t* W1 = (bf16_t*)(c.ws + WS_W1); bf16_t* W2 = (bf16_t*)(c.ws + WS_W2); bf16_t* XN = (bf16_t*)(c.ws + WS_XN); bf16_t* Mb = (bf16_t*)(c.ws + WS_M);
    bf16_t* BIG = (bf16_t*)(c.ws + WS_BIG); bf16_t* ACT = (bf16_t*)(c.ws + WS_ACT); bf16_t* Yb = (bf16_t*)(c.ws + WS_Y); float* DT = (float*)(c.ws + WS_DT);

    if (PMASK & 1) rowwise_phase(c, inp(c, 0), nullptr, nullptr, c.out, XN, false);
    REFRESH();
    if (PMASK & 2) convert_phase(c, 0, 0);
    grid.sync();
#pragma unroll 1
    for (int sl = 0; sl < 8; ++sl) {
        const int i = sl >> 1, j = i >> 1; const bool ffn = sl & 1, ssm = !(i & 1);
        REFRESH();
        if (PMASK & 4) {
            const int N = ffn ? NUP : (ssm ? NINP : NQKV), nmain = ffn ? NUP : (ssm ? NPROJ : NQKV);
            pg8::Gemm g{XN, W1, MROWS, N, DM, DM}; pg8::StaticOrder S; S.init(MROWS, N, (int)gridDim.x, c.bid);
            pg8::EpiStore E{BIG, nmain, nmain, (!ffn && ssm) ? DT : nullptr};
            pg8::gemm_phase<pg8::EpiStore, pg8::StaticOrder, true, true>(c.lds, g, S, E);
        }
        grid.sync();
        REFRESH();
        if (ffn) { if (PMASK & 8) ffn_gate_phase(c, i); }
        else if (ssm) { if (PMASK & 16) ssd_states_phase(c, j); grid.sync(); REFRESH(); if (PMASK & 32) ssd_scan_phase(c); grid.sync(); REFRESH(); if (PMASK & 64) ssd_out_phase(c, j); }
        else { if (PMASK & 128) attn_phase(c, i); }
        grid.sync();
        REFRESH();
        if (PMASK & 4) {
            const int K = ffn ? DFF : (ssm ? DIN : DM); const bf16_t* A = ffn ? ACT : Yb;
            pg8::Gemm g{A, W2, MROWS, DM, K, K}; pg8::StaticOrder S; S.init(MROWS, DM, (int)gridDim.x, c.bid);
            pg8::EpiStore E{Mb, DM, DM, nullptr};
            pg8::gemm_phase<pg8::EpiStore, pg8::StaticOrder, true, true>(c.lds, g, S, E);
        }
        grid.sync();
        REFRESH();
        if (PMASK & 1) rowwise_phase(c, nullptr, Mb, (ffn ? inp(c, 19) : inp(c, 17)) + i * DM, c.out, XN, sl == 7);
        REFRESH();
        if (PMASK & 2) { if (!ffn) convert_phase(c, 2, i);
        else if (i < 3) convert_phase(c, ((i + 1) & 1) ? 1 : 0, i + 1); }
        if (sl < 7) grid.sync();
    }
}

extern "C" void kernel_launch(void* const* d_in, const int* in_sizes, int n_in, void* d_out, int out_size, void* d_ws, size_t ws_size, hipStream_t stream) {
    static int grid_blocks = 0;
    if (grid_blocks == 0) {
        if (n_in != 24 || in_sizes[0] != MROWS * DM || out_size != MROWS * DM || ws_size < WS_END) {
            fprintf(stderr, "kernel_launch: unexpected problem (n_in %d, in0 %d, out %d, ws %zu < %zu?); nothing launched\n", n_in, n_in > 0 ? in_sizes[0] : -1, out_size, ws_size, (size_t)WS_END); grid_blocks = -1; return; }
        int dev = 0, cus = 0, per_cu = 0;
        hipGetDevice(&dev); hipDeviceGetAttribute(&cus, hipDeviceAttributeMultiprocessorCount, dev);
        if (hipFuncSetAttribute((const void*)hybrid_fwd, hipFuncAttributeMaxDynamicSharedMemorySize, LDS_BYTES) != hipSuccess) { fprintf(stderr, "kernel_launch: hipFuncSetAttribute failed\n"); grid_blocks = -1; return; }
        if (hipOccupancyMaxActiveBlocksPerMultiprocessor(&per_cu, (const void*)hybrid_fwd, 512, LDS_BYTES) != hipSuccess || per_cu < 1) { fprintf(stderr, "kernel_launch: occupancy query says %d\n", per_cu); per_cu = 1; }
        (void)hipGetLastError();
        grid_blocks = cus * (per_cu > 1 ? 1 : per_cu);
    }
    if (grid_blocks < 0) return;
    Args a{};
    for (int k = 0; k < 24; ++k) a.in[k] = (const float*)d_in[k];
    a.out = (float*)d_out; a.ws = (unsigned char*)d_ws;
    void* args[] = {&a};
    hipError_t e = hipLaunchCooperativeKernel((const void*)hybrid_fwd, dim3(grid_blocks), dim3(512), args, LDS_BYTES, stream);
    if (e != hipSuccess) fprintf(stderr, "kernel_launch: cooperative launch failed: %s (grid %d)\n", hipGetErrorString(e), grid_blocks);
}
```

```cpp
#include <hip/hip_runtime.h>
#include <hip/hip_cooperative_groups.h>
#include <cstdio>
#include <cstdint>
namespace cg = cooperative_groups;
#ifndef PMASK
#define PMASK 0xff
#endif
#ifndef DUP
#define DUP 0
#endif
#define NREP(bit) ((DUP & (bit)) ? 2 : 1)
#ifndef SUB
#define SUB 0
#endif
#define SREP(bit) ((SUB & (bit)) ? 2 : 1)

#define DI __device__ __forceinline__
#define LAS __attribute__((address_space(3)))
typedef unsigned short bf16_t;
typedef short bf16x8 __attribute__((ext_vector_type(8)));
typedef short s16x4 __attribute__((ext_vector_type(4)));
typedef float f32x4 __attribute__((ext_vector_type(4)));
typedef float f32x16 __attribute__((ext_vector_type(16)));
typedef unsigned u32x4 __attribute__((ext_vector_type(4)));
typedef unsigned u32x2 __attribute__((ext_vector_type(2)));
typedef __bf16 bf16x2_t __attribute__((ext_vector_type(2)));
typedef float f32x2_t __attribute__((ext_vector_type(2)));

DI unsigned cvtpk(float lo, float hi) { f32x2_t v = {lo, hi}; bf16x2_t b = __builtin_convertvector(v, bf16x2_t); return __builtin_bit_cast(unsigned, b); }
DI float bflo(unsigned w) { return __uint_as_float(w << 16); }
DI float bfhi(unsigned w) { return __uint_as_float(w & 0xffff0000u); }
DI float bf1(bf16_t b) { return __uint_as_float((unsigned)b << 16); }
DI float silu_f(float x) { return x * __builtin_amdgcn_rcpf(1.0f + __expf(-x)); }
DI float wave_sum(float v) {
#pragma unroll
    for (int o = 1; o < 64; o <<= 1) v += __shfl_xor(v, o);
    return v;
}
DI int crow(int reg, int h) { return (reg & 3) + 8 * (reg >> 2) + 4 * h; }
#define MFMA32(a, b, c) __builtin_amdgcn_mfma_f32_32x32x16_bf16((a), (b), (c), 0, 0, 0)
#define LDS_WAIT() asm volatile("s_waitcnt lgkmcnt(0)" ::: "memory")

constexpr int NB = 4, SEQ = 4096, DM = 1024, MROWS = NB * SEQ;
constexpr int DIN = 2048, NPROJ = 6144, NIN = 6176, NINP = 6400, DFF = 2816, NUP = 5632, NQKV = 3072, XBC = 4096;
constexpr float EPS = 1e-6f;
constexpr float LOG2E = 1.4426950408889634f;
constexpr size_t MiB = 1u << 20;
constexpr size_t WS_CD = 0;
constexpr size_t WS_BAR = 64 * 1024;
constexpr size_t WS_DT = 1 * MiB;
constexpr size_t WS_W1 = 3 * MiB;
constexpr size_t WS_W2 = 16 * MiB;
constexpr size_t WS_XN = 22 * MiB;
constexpr size_t WS_M = 54 * MiB;
constexpr size_t WS_ST = 22 * MiB;
constexpr size_t WS_BIG = 86 * MiB;
constexpr size_t WS_KVB = 86 * MiB + 96 * MiB;
constexpr size_t WS_ACT = 262 * MiB;
constexpr size_t WS_Y = 278 * MiB;
constexpr size_t WS_END = 350 * MiB;
DI size_t pblk(int row, int col) {
    const int b = row >> 12, s = row & 4095;
    if (col < 2048) return ((size_t)((b * 8 + (col >> 8)) * 4096 + s)) * 256 + (col & 255);
    if (col < 4096) { const int cc = col - 2048; return (size_t)33554432 + ((size_t)((b * 8 + (cc >> 8)) * 4096 + s)) * 256 + (cc & 255); }
    if (col < 5120) { const int cc = col - 4096; return (size_t)67108864 + ((size_t)((b * 8 + (cc >> 7)) * 4096 + s)) * 128 + (cc & 127); }
    const int cc = col - 5120; return (size_t)83886080 + ((size_t)((b * 8 + (cc >> 7)) * 4096 + s)) * 128 + (cc & 127);
}
constexpr int LDS_BYTES = 155648;

namespace pg8 {
#define PG8_LAS __attribute__((address_space(3)))
constexpr int BM = 256, BK = 64, HALF = 128, HTB = HALF * BK * 2  , STAGE_BYTES = 8 * HTB, NXCD = 8, WGM = 8;

__host__ __device__ __forceinline__ int lds_byte(int r, int c) { const int st = (r >> 4) * 2 + (c >> 5), rr = r & 15, cc = c & 31, ob = rr * 64 + cc * 2; return st * 1024 + (ob ^ (((ob >> 9) & 1) << 5)); }
__host__ __device__ __forceinline__ void stage_rc(int b, int& R, int& C) { const int st = b / 1024, sb = b % 1024, swz = sb ^ (((sb >> 9) & 1) << 5); R = (st >> 1) * 16 + swz / 64; C = (st & 1) * 32 + (swz % 64) / 2; }
__host__ __device__ __forceinline__ int perm32(int rho) { const int n = rho >> 4, i = rho & 15; return 8 * (i >> 2) + 4 * n + (i & 3); }

struct Unit { int pm, pn; };
struct Gemm { const bf16_t* A; const bf16_t* Bt; int M, N, K, lda; };

struct StaticOrder {
    int nM, nN, nwg, G, c;
    __host__ __device__ void init(int M, int N, int G_, int c_) { nM = M / BM; nN = N / BM; nwg = nM * nN; G = G_; c = c_; }
    __host__ __device__ bool next(int i, Unit& u) const {
        const long L = (long)i * G + c; if (L >= nwg) return false;
        int wgid = (int)L; { const int q = nwg / NXCD, r = nwg % NXCD, xcd = wgid % NXCD, off = wgid / NXCD; wgid = (xcd < r ? xcd * (q + 1) : r * (q + 1) + (xcd - r) * q) + off; }
        const int nig = WGM * nN, gid = wgid / nig, fm = gid * WGM, gsz = (nM - fm) < WGM ? (nM - fm) : WGM;
        u.pm = fm + ((wgid % nig) % gsz); u.pn = (wgid % nig) / gsz; return true;
    }
    __device__ __forceinline__ void a_ready(const Unit&) const {}
    __device__ __forceinline__ void done(const Unit&) const {}
};

template <class Epi, class Sched, bool ALIGN_EPI = false, bool SP2 = false>
__device__ __forceinline__ void gemm_phase(PG8_LAS unsigned char* lds, const Gemm g, const Sched& S, const Epi& E) {
    int tid_ = threadIdx.x; asm volatile("" : "+v"(tid_));
    const int tid = tid_, wid = __builtin_amdgcn_readfirstlane(tid >> 6), lane = tid & 63, wr = wid >> 2, wc = wid & 3, fr = lane & 15, fq = lane >> 4;
    const int K = g.K, nt = K / BK;
    unsigned voffA[2], voffB[2];
#pragma unroll
    for (int i = 0; i < 2; ++i) { int R, C; stage_rc(tid * 16 + i * 8192, R, C); const int Rb = Epi::PERM ? ((R & ~31) + perm32(R & 31)) : R;
        voffA[i] = (unsigned)(R * g.lda + C) * 2u; voffB[i] = (unsigned)(Rb * K + C) * 2u; }
    const size_t kstep = (size_t)(BK * 2);
    const size_t hstep = (size_t)HALF * K * 2;
    const size_t tstep = 2 * hstep; const size_t hstepA = (size_t)HALF * g.lda * 2, tstepA = 2 * hstepA;
    const unsigned ldsw = (unsigned)wid * 1024u;
    const int aoff = lds_byte(wr * 64 + fr, fq * 8), boff = lds_byte(wc * 32 + fr, fq * 8);
#define PG8_SA(b, h) (((b) * 2 + (h)) * HTB)
#define PG8_SB(b, h) ((4 + (b) * 2 + (h)) * HTB)
#define PG8_STAGE(bufoff, gbase, voff) do { _Pragma("unroll") for (int _i = 0; _i < 2; ++_i) \
        __builtin_amdgcn_global_load_lds((const unsigned*)((const char*)(gbase) + (voff)[_i]), (PG8_LAS unsigned*)(lds + (bufoff) + ldsw + _i * 8192), 16, 0, 0); } while (0)
#define PG8_LDA(dst, b, h) do { _Pragma("unroll") for (int m = 0; m < 4; ++m) _Pragma("unroll") for (int k = 0; k < 2; ++k) dst[m][k] = *(const PG8_LAS bf16x8*)(lds + PG8_SA(b, h) + aoff + m * 2048 + k * 1024); } while (0)
#define PG8_LDB(dst, b, h) do { _Pragma("unroll") for (int n = 0; n < 2; ++n) _Pragma("unroll") for (int k = 0; k < 2; ++k) dst[n][k] = *(const PG8_LAS bf16x8*)(lds + PG8_SB(b, h) + boff + n * 2048 + k * 1024); } while (0)
#define PG8_MMA(ai, bj, At, Bt) do { __builtin_amdgcn_s_setprio(1); _Pragma("unroll") for (int m = 0; m < 4; ++m) _Pragma("unroll") for (int n = 0; n < 2; ++n) _Pragma("unroll") for (int k = 0; k < 2; ++k) \
        acc[ai][bj][m][n] = __builtin_amdgcn_mfma_f32_16x16x32_bf16(Bt[n][k], At[m][k], acc[ai][bj][m][n], 0, 0, 0); __builtin_amdgcn_s_setprio(0); } while (0)
#define PG8_WAIT_V(n) asm volatile("s_waitcnt vmcnt(" #n ")" ::: "memory")
#define PG8_WAIT_L(n) asm volatile("s_waitcnt lgkmcnt(" #n ")" ::: "memory")
#define PG8_BAR __builtin_amdgcn_s_barrier()
#define PG8_SCHED __builtin_amdgcn_sched_barrier(0)
    Unit cur, nxt; int ui = 0;
    if (!S.next(0, cur)) return;
    f32x4 acc[2][2][4][2];
#pragma unroll
    for (int a = 0; a < 2; ++a)
#pragma unroll
        for (int b = 0; b < 2; ++b)
#pragma unroll
            for (int m = 0; m < 4; ++m)
#pragma unroll
                for (int n = 0; n < 2; ++n) acc[a][b][m][n] = (f32x4){0.f, 0.f, 0.f, 0.f};
    bf16x8 At[4][2], B0[2][2], B1[2][2];
    const char* cA = (const char*)g.A + (size_t)cur.pm * tstepA; const char* cB = (const char*)g.Bt + (size_t)cur.pn * tstep;
    S.a_ready(cur);
    if constexpr (SP2) {
        PG8_STAGE(PG8_SB(0, 0), cB, voffB); PG8_STAGE(PG8_SB(0, 1), cB + hstep, voffB); PG8_STAGE(PG8_SA(0, 0), cA, voffA); PG8_STAGE(PG8_SA(0, 1), cA + hstepA, voffA);
        if (wr == 1) PG8_BAR;
        PG8_WAIT_V(2); PG8_BAR;
        PG8_STAGE(PG8_SB(1, 0), cB + kstep, voffB); PG8_STAGE(PG8_SA(1, 0), cA + kstep, voffA); PG8_STAGE(PG8_SB(1, 1), cB + hstep + kstep, voffB);
        PG8_WAIT_V(6); PG8_BAR;
    } else {
        PG8_STAGE(PG8_SB(0, 0), cB, voffB); PG8_STAGE(PG8_SA(0, 0), cA, voffA); PG8_STAGE(PG8_SB(0, 1), cB + hstep, voffB); PG8_STAGE(PG8_SA(0, 1), cA + hstepA, voffA);
        if (wr == 1) PG8_BAR;
        PG8_WAIT_V(4); PG8_BAR;
        PG8_STAGE(PG8_SB(1, 0), cB + kstep, voffB); PG8_STAGE(PG8_SA(1, 0), cA + kstep, voffA); PG8_STAGE(PG8_SB(1, 1), cB + hstep + kstep, voffB);
        PG8_WAIT_V(6); PG8_BAR;
    }
    for (;;) {
        const bool has_next = S.next(ui + 1, nxt);
        const char* nA = has_next ? (const char*)g.A + (size_t)nxt.pm * tstepA : cA; const char* nB = has_next ? (const char*)g.Bt + (size_t)nxt.pn * tstep : cB;
        for (int t = 0; t < nt; t += 2) {
            const bool last = (t == nt - 2);
            const char* a1 = cA + (size_t)(t + 1) * kstep;
            const char* a2 = last ? nA : cA + (size_t)(t + 2) * kstep; const char* b2 = last ? nB : cB + (size_t)(t + 2) * kstep;
            const char* a3 = a2 + kstep; const char* b3 = b2 + kstep;
            if (last && has_next) S.a_ready(nxt);
            if constexpr (SP2) {
            PG8_LDB(B0, 0, 0); PG8_LDB(B1, 0, 1); PG8_SCHED; PG8_LDA(At, 0, 0); PG8_STAGE(PG8_SA(1, 1), a1 + hstepA, voffA);
            PG8_WAIT_V(8); PG8_WAIT_L(0); PG8_BAR; PG8_MMA(0, 0, At, B0); PG8_MMA(0, 1, At, B1); PG8_BAR; PG8_SCHED;
            PG8_LDA(At, 0, 1); PG8_STAGE(PG8_SB(0, 0), b2, voffB); PG8_STAGE(PG8_SB(0, 1), b2 + hstep, voffB); PG8_STAGE(PG8_SA(0, 0), a2, voffA);
            PG8_WAIT_V(8); PG8_WAIT_L(0); PG8_BAR; PG8_MMA(1, 0, At, B0); PG8_MMA(1, 1, At, B1); PG8_BAR; PG8_SCHED;
            PG8_LDB(B0, 1, 0); PG8_LDB(B1, 1, 1); PG8_SCHED; PG8_LDA(At, 1, 0); PG8_STAGE(PG8_SA(0, 1), a2 + hstepA, voffA);
            PG8_WAIT_V(8); PG8_WAIT_L(0); PG8_BAR; PG8_MMA(0, 0, At, B0); PG8_MMA(0, 1, At, B1); PG8_BAR; PG8_SCHED;
            PG8_LDA(At, 1, 1); PG8_STAGE(PG8_SB(1, 0), b3, voffB); PG8_STAGE(PG8_SB(1, 1), b3 + hstep, voffB); PG8_STAGE(PG8_SA(1, 0), a3, voffA);
            PG8_WAIT_V(8); PG8_WAIT_L(0); PG8_BAR; PG8_MMA(1, 0, At, B0); PG8_MMA(1, 1, At, B1); PG8_BAR; PG8_SCHED;
            } else {
            PG8_LDB(B0, 0, 0); PG8_SCHED; PG8_LDA(At, 0, 0); PG8_STAGE(PG8_SA(1, 1), a1 + hstepA, voffA);
            PG8_WAIT_L(8); PG8_BAR; PG8_WAIT_L(0); PG8_MMA(0, 0, At, B0); PG8_BAR; PG8_SCHED;
            PG8_LDB(B1, 0, 1); PG8_STAGE(PG8_SB(0, 0), b2, voffB);
            PG8_BAR; PG8_WAIT_L(0); PG8_MMA(0, 1, At, B1); PG8_BAR;
            PG8_LDA(At, 0, 1); PG8_STAGE(PG8_SA(0, 0), a2, voffA);
            PG8_BAR; PG8_WAIT_L(0); PG8_MMA(1, 0, At, B0); PG8_BAR; PG8_SCHED;
            PG8_STAGE(PG8_SB(0, 1), b2 + hstep, voffB);
            PG8_WAIT_V(6); PG8_BAR; PG8_MMA(1, 1, At, B1); PG8_BAR;
            PG8_LDB(B0, 1, 0); PG8_SCHED; PG8_LDA(At, 1, 0); PG8_STAGE(PG8_SA(0, 1), a2 + hstepA, voffA);
            PG8_WAIT_L(8); PG8_BAR; PG8_WAIT_L(0); PG8_MMA(0, 0, At, B0); PG8_BAR; PG8_SCHED;
            PG8_LDB(B1, 1, 1); PG8_STAGE(PG8_SB(1, 0), b3, voffB);
            PG8_BAR; PG8_WAIT_L(0); PG8_MMA(0, 1, At, B1); PG8_BAR;
            PG8_LDA(At, 1, 1); PG8_STAGE(PG8_SA(1, 0), a3, voffA);
            PG8_BAR; PG8_WAIT_L(0); PG8_MMA(1, 0, At, B0); PG8_BAR; PG8_SCHED;
            PG8_STAGE(PG8_SB(1, 1), b3 + hstep, voffB);
            PG8_WAIT_V(6); PG8_BAR; PG8_MMA(1, 1, At, B1); PG8_BAR;
            }
        }
        if constexpr (ALIGN_EPI) { if (wr == 0) PG8_BAR; }
        if constexpr (!Epi::AFTER_DRAIN) { E(acc, cur, wr, wc, fr, fq); S.done(cur); }
        if (!has_next) break;
#pragma unroll
        for (int a = 0; a < 2; ++a)
#pragma unroll
            for (int b = 0; b < 2; ++b)
#pragma unroll
                for (int m = 0; m < 4; ++m)
#pragma unroll
                    for (int n = 0; n < 2; ++n) acc[a][b][m][n] = (f32x4){0.f, 0.f, 0.f, 0.f};
        cur = nxt; cA = nA; cB = nB; ++ui;
        if constexpr (ALIGN_EPI) { if (wr == 1) PG8_BAR; }
    }
    PG8_WAIT_V(0);
    if constexpr (!ALIGN_EPI) { if (wr == 0) PG8_BAR; }
    PG8_BAR;
    if constexpr (Epi::AFTER_DRAIN) { E.fused(acc, cur, wr, wc, fr, fq, lds, wid, lane); S.done(cur); }
#undef PG8_SA
#undef PG8_SB
#undef PG8_STAGE
#undef PG8_LDA
#undef PG8_LDB
#undef PG8_MMA
#undef PG8_WAIT_V
#undef PG8_WAIT_L
#undef PG8_BAR
#undef PG8_SCHED
}

}

namespace pg8 {
struct EpiStore {
    static constexpr bool PERM = true, AFTER_DRAIN = false;
    bf16_t* O; int ldc; int nmain; float* dt; int nsilu; bf16_t* kvb; int pblocked;
    __device__ __forceinline__ void operator()(const f32x4 (&acc)[2][2][4][2], const Unit& u, int wr, int wc, int fr, int fq) const {
        const int row0 = u.pm * BM + wr * 64 + fr; const int colt = u.pn * BM;
        if (colt < nmain) {
            const int col0 = colt + wc * 32 + 8 * fq;
#pragma unroll
            for (int ai = 0; ai < 2; ++ai)
#pragma unroll
                for (int m = 0; m < 4; ++m) { const int grow = row0 + ai * HALF + m * 16; bf16_t* rowp = O + (size_t)grow * ldc + col0;
#pragma unroll
                    for (int bj = 0; bj < 2; ++bj) { f32x4 v0 = acc[ai][bj][m][0], v1 = acc[ai][bj][m][1];
                        if (colt < nsilu) {
#pragma unroll
                            for (int e = 0; e < 4; ++e) { v0[e] = silu_f(v0[e]); v1[e] = silu_f(v1[e]); } }
                        u32x4 w; w.x = cvtpk(v0[0], v0[1]); w.y = cvtpk(v0[2], v0[3]); w.z = cvtpk(v1[0], v1[1]); w.w = cvtpk(v1[2], v1[3]);
                        bf16_t* sp = rowp + bj * HALF;
                        if (kvb != nullptr && colt >= 1024) {
                            const int bb = grow >> 12, ss = grow & 4095;
                            if (colt < 2048) { const int cc = col0 + bj * HALF - 1024; sp = kvb + ((size_t)(((bb * 8 + (cc >> 7)) * 2 + ((cc >> 6) & 1)) * 4096 + ss)) * 64 + (cc & 63); }
                            else { const int cc = col0 + bj * HALF - 2048; sp = kvb + (size_t)4 * 8 * 2 * 4096 * 64 + ((size_t)((bb * 8 + (cc >> 7)) * 4096 + ss)) * 128 + (cc & 127); }
                        }
                        if (pblocked) { const int colb = colt + bj * HALF; const unsigned rs = (colb < 4096) ? 256u : 128u;
                            sp = O + pblk(u.pm * BM, colb) + (unsigned)(grow - u.pm * BM) * rs + (unsigned)(col0 - colt); }
                        *(u32x4*)sp = w; } }
        } else if (dt != nullptr && wc == 0) {
#pragma unroll
            for (int ai = 0; ai < 2; ++ai)
#pragma unroll
                for (int m = 0; m < 4; ++m) { float* p = dt + (size_t)(row0 + ai * HALF + m * 16) * 32 + 8 * fq;
                    *(f32x4*)p = acc[ai][0][m][0]; *(f32x4*)(p + 4) = acc[ai][0][m][1]; }
        }
    }
};
}

DI void transpose_item(const float* W, int K, int N, bf16_t* WT, LAS float* scr, int item, int lane, const float* gk, int gmask, float gscale, int nq, float qscale) {
    const int nblk = (N + 63) / 64, kb = item / nblk, nb = item % nblk, k0 = 64 * kb, n0 = 64 * nb;
    const bool colok = (n0 + lane) < N;
    const float* src = W + (size_t)k0 * N + n0 + (colok ? lane : 0);
    float v[64];
#pragma unroll
    for (int kk = 0; kk < 64; ++kk) v[kk] = __builtin_nontemporal_load(src + (size_t)kk * N);
#pragma unroll
    for (int kk = 0; kk < 64; ++kk) { const float g = gk ? gk[(k0 + kk) & gmask] * gscale : 1.0f; scr[kk * 65 + lane] = v[kk] * g; }
    LDS_WAIT(); asm volatile("" ::: "memory");
    const int c = lane & 7;
#pragma unroll
    for (int j = 0; j < 8; ++j) { const int n = (lane >> 3) + 8 * j; const LAS float* s = scr + (8 * c) * 65 + n; const float cs = (n0 + n < nq) ? qscale : 1.0f;
        u32x4 o; o.x = cvtpk(s[0 * 65] * cs, s[1 * 65] * cs); o.y = cvtpk(s[2 * 65] * cs, s[3 * 65] * cs); o.z = cvtpk(s[4 * 65] * cs, s[5 * 65] * cs); o.w = cvtpk(s[6 * 65] * cs, s[7 * 65] * cs);
        if (n0 + n < N) *(u32x4*)(WT + (size_t)(n0 + n) * K + k0 + 8 * c) = o; }
    LDS_WAIT(); asm volatile("" ::: "memory");
}

struct Ctx {
    float* out; unsigned char* ws;
    LAS unsigned char* lds;
    int tid, lane, wid, gw, ngw, bid;
};
constexpr int PTR_OFF = LDS_BYTES - 256;
DI const float* inp(const Ctx& c, int k) {
    const unsigned long long v = ((const LAS unsigned long long*)(c.lds + PTR_OFF))[k];
    const unsigned lo = __builtin_amdgcn_readfirstlane((unsigned)v), hi = __builtin_amdgcn_readfirstlane((unsigned)(v >> 32));
    return (const float*)(((unsigned long long)hi << 32) | lo);
}
DI float lambda_init(int i) { return (i == 1) ? 0.35550906759096926f : 0.5560582041556405f; }

DI void convert_phase(const Ctx& c, int kind, int i) {
    LAS float* scr = (LAS float*)(c.lds + c.wid * 16640);
    bf16_t* W1 = (bf16_t*)(c.ws + WS_W1); bf16_t* W2 = (bf16_t*)(c.ws + WS_W2);
    const int j = i >> 1;
    const float* WA; const float* WB; int KA = DM, NA, KB, NB_ = DM; const float* gA; const float* gB = nullptr; int maskB = 0; float gsB = 1.0f; int nq = 0; float qs = 1.0f;
    if (kind == 0) { WA = inp(c, 1) + (size_t)j * DM * NIN; NA = NIN; gA = inp(c, 16) + i * DM; WB = inp(c, 8) + (size_t)j * DIN * DM; KB = DIN; gB = inp(c, 7) + j * DIN; maskB = DIN - 1; }
    else if (kind == 1) { WA = inp(c, 9) + (size_t)j * DM * NQKV; NA = NQKV; gA = inp(c, 16) + i * DM; nq = DM; qs = 0.125f * LOG2E;
                          WB = inp(c, 15) + (size_t)j * DM * DM; KB = DM; gB = inp(c, 14) + j * 128; maskB = 127; gsB = 1.0f - lambda_init(i); }
    else { WA = inp(c, 20) + (size_t)i * DM * NUP; NA = NUP; gA = inp(c, 18) + i * DM; WB = inp(c, 23) + (size_t)i * DFF * DM; KB = DFF; }
    const int nA = (KA / 64) * ((NA + 63) / 64), nB = (KB / 64) * (NB_ / 64);
    for (int it = c.gw; it < nA + nB; it += c.ngw) {
        if (it < nA) transpose_item(WA, KA, NA, W1, scr, it, c.lane, gA, DM - 1, 1.0f, nq, qs);
        else transpose_item(WB, KB, NB_, W2, scr, it - nA, c.lane, gB, maskB, gsB, 0, 1.0f);
    }
    if (kind == 0) {
        u32x4* z = (u32x4*)(W1 + (size_t)NIN * DM); const int n16 = (NINP - NIN) * DM / 8;
        for (int t = c.gw * 64 + c.lane; t < n16; t += c.ngw * 64) z[t] = (u32x4){0u, 0u, 0u, 0u};
    }
}

DI void rowwise_phase(const Ctx& c, const float* xin, const bf16_t* Mb, const float* gpost, const float* xsrc, float* xres, bf16_t* XN, bool last) {
    constexpr int RB = 4;
    for (int row0 = c.gw * RB; row0 < MROWS; row0 += c.ngw * RB) {
        f32x4 v[RB][4];
        if (xin) {
#pragma unroll
            for (int rr = 0; rr < RB; ++rr)
#pragma unroll
                for (int j = 0; j < 4; ++j) v[rr][j] = __builtin_nontemporal_load((const f32x4*)(xin + (size_t)(row0 + rr) * DM + 4 * c.lane + 256 * j));
        } else {
            u32x2 mw[RB][4]; f32x4 g[4];
#pragma unroll
            for (int rr = 0; rr < RB; ++rr)
#pragma unroll
                for (int j = 0; j < 4; ++j) { mw[rr][j] = __builtin_nontemporal_load((const u32x2*)(Mb + (size_t)(row0 + rr) * DM + 4 * c.lane + 256 * j)); v[rr][j] = __builtin_nontemporal_load((const f32x4*)(xsrc + (size_t)(row0 + rr) * DM + 4 * c.lane + 256 * j)); }
#pragma unroll
            for (int j = 0; j < 4; ++j) g[j] = *(const f32x4*)(gpost + 4 * c.lane + 256 * j);
#pragma unroll
            for (int rr = 0; rr < RB; ++rr) {
                f32x4 mv[4]; float ss = 0.f;
#pragma unroll
                for (int j = 0; j < 4; ++j) { const u32x2 w = mw[rr][j]; mv[j] = (f32x4){bflo(w.x), bfhi(w.x), bflo(w.y), bfhi(w.y)}; ss += (mv[j].x * mv[j].x + mv[j].y * mv[j].y) + (mv[j].z * mv[j].z + mv[j].w * mv[j].w); }
                const float rm = rsqrtf(wave_sum(ss) * (1.0f / DM) + EPS);
#pragma unroll
                for (int j = 0; j < 4; ++j) v[rr][j] = v[rr][j] + mv[j] * rm * g[j];
            }
        }
#pragma unroll
        for (int rr = 0; rr < RB; ++rr) {
            if (xres) {
#pragma unroll
                for (int j = 0; j < 4; ++j) __builtin_nontemporal_store(v[rr][j], (f32x4*)(xres + (size_t)(row0 + rr) * DM + 4 * c.lane + 256 * j));
            }
            if (!last) {
                float s2 = 0.f;
#pragma unroll
                for (int j = 0; j < 4; ++j) s2 += (v[rr][j].x * v[rr][j].x + v[rr][j].y * v[rr][j].y) + (v[rr][j].z * v[rr][j].z + v[rr][j].w * v[rr][j].w);
                const float rs = rsqrtf(wave_sum(s2) * (1.0f / DM) + EPS);
#pragma unroll
                for (int j = 0; j < 4; ++j) { u32x2 o; o.x = cvtpk(v[rr][j].x * rs, v[rr][j].y * rs); o.y = cvtpk(v[rr][j].z * rs, v[rr][j].w * rs); *(u32x2*)(XN + (size_t)(row0 + rr) * DM + 4 * c.lane + 256 * j) = o; }
            }
        }
    }
}

DI void ffn_gate_phase(const Ctx& c, int i) {
    const bf16_t* H = (const bf16_t*)(c.ws + WS_BIG); bf16_t* ACT = (bf16_t*)(c.ws + WS_ACT);
    const float* cw = inp(c, 21) + (size_t)i * 3 * NUP; const float* cb = inp(c, 22) + (size_t)i * NUP;
    constexpr int NCH = DFF / 8, RUN = 8, NRUN = MROWS / RUN;
    const int gt = c.bid * 512 + c.tid, nrg = (gridDim.x * 512) / NCH;
    if (gt >= nrg * NCH) return;
    const int ch = gt % NCH, rg = gt / NCH, col = ch * 8;
    float wg[3][8], wu[3][8], bg[8], bu[8];
#pragma unroll
    for (int k = 0; k < 3; ++k) {
        const f32x4 a0 = *(const f32x4*)(cw + k * NUP + col), a1 = *(const f32x4*)(cw + k * NUP + col + 4);
        const f32x4 b0 = *(const f32x4*)(cw + k * NUP + DFF + col), b1 = *(const f32x4*)(cw + k * NUP + DFF + col + 4);
#pragma unroll
        for (int e = 0; e < 4; ++e) { wg[k][e] = a0[e]; wg[k][4 + e] = a1[e]; wu[k][e] = b0[e]; wu[k][4 + e] = b1[e]; }
    }
    { const f32x4 a0 = *(const f32x4*)(cb + col), a1 = *(const f32x4*)(cb + col + 4), b0 = *(const f32x4*)(cb + DFF + col), b1 = *(const f32x4*)(cb + DFF + col + 4);
#pragma unroll
      for (int e = 0; e < 4; ++e) { bg[e] = a0[e]; bg[4 + e] = a1[e]; bu[e] = b0[e]; bu[4 + e] = b1[e]; } }
#pragma unroll 1
    for (int run = rg; run < NRUN; run += nrg) {
        const int row0 = run * RUN; const bool first = (row0 & (SEQ - 1)) == 0;
        u32x4 ga[RUN + 2], ua[RUN + 2];
#pragma unroll
        for (int r = 0; r < RUN + 2; ++r) {
            if (r < 2 && first) { ga[r] = (u32x4){0u, 0u, 0u, 0u}; ua[r] = (u32x4){0u, 0u, 0u, 0u}; }
            else { ga[r] = __builtin_nontemporal_load((const u32x4*)(H + (size_t)(row0 + r - 2) * NUP + col)); ua[r] = __builtin_nontemporal_load((const u32x4*)(H + (size_t)(row0 + r - 2) * NUP + DFF + col)); }
        }
        float g2[8], g1[8], u2[8], u1[8];
#pragma unroll
        for (int e = 0; e < 4; ++e) { g2[2 * e] = bflo(ga[0][e]); g2[2 * e + 1] = bfhi(ga[0][e]); g1[2 * e] = bflo(ga[1][e]); g1[2 * e + 1] = bfhi(ga[1][e]);
                                      u2[2 * e] = bflo(ua[0][e]); u2[2 * e + 1] = bfhi(ua[0][e]); u1[2 * e] = bflo(ua[1][e]); u1[2 * e + 1] = bfhi(ua[1][e]); }
#pragma unroll
        for (int r = 0; r < RUN; ++r) {
            float g0[8], u0[8], o[8];
#pragma unroll
            for (int e = 0; e < 4; ++e) { g0[2 * e] = bflo(ga[r + 2][e]); g0[2 * e + 1] = bfhi(ga[r + 2][e]); u0[2 * e] = bflo(ua[r + 2][e]); u0[2 * e + 1] = bfhi(ua[r + 2][e]); }
#pragma unroll
            for (int e = 0; e < 8; ++e) { const float yg = bg[e] + wg[0][e] * g2[e] + wg[1][e] * g1[e] + wg[2][e] * g0[e]; const float yu = bu[e] + wu[0][e] * u2[e] + wu[1][e] * u1[e] + wu[2][e] * u0[e];
                o[e] = silu_f(yg) * yu; g2[e] = g1[e]; g1[e] = g0[e]; u2[e] = u1[e]; u1[e] = u0[e]; }
            u32x4 w; w.x = cvtpk(o[0], o[1]); w.y = cvtpk(o[2], o[3]); w.z = cvtpk(o[4], o[5]); w.w = cvtpk(o[6], o[7]);
            *(u32x4*)(ACT + (size_t)(row0 + r) * DFF + col) = w;
        }
    }
}

DI void ssm_conv8(const bf16_t* proj, int row, int t, int ch, const float (&w)[4][8], const float (&b)[8], float (&o)[8]) {
#pragma unroll
    for (int e = 0; e < 8; ++e) o[e] = b[e];
#pragma unroll
    for (int k = 0; k < 4; ++k) {
        if (t - 3 + k >= 0) {
            const u32x4 v = *(const u32x4*)(proj + (size_t)(row - 3 + k) * NPROJ + DIN + ch);
#pragma unroll
            for (int e = 0; e < 4; ++e) { o[2 * e] += w[k][2 * e] * bflo(v[e]); o[2 * e + 1] += w[k][2 * e + 1] * bfhi(v[e]); }
        }
    }
#pragma unroll
    for (int e = 0; e < 8; ++e) o[e] = silu_f(o[e]);
}
DI void ssm_conv_run4(const bf16_t* proj, int row, int t, int ch, const float (&w)[4][8], const float (&b)[8], float (&o)[4][8]) {
    u32x4 raw[7];
    const bf16_t* p3 = proj + pblk(row, DIN + ch); const int rs = (ch < 2048) ? 256 : 128;
#pragma unroll
    for (int k = 0; k < 7; ++k) { if (k < 3 && t == 0) raw[k] = (u32x4){0u, 0u, 0u, 0u}; else raw[k] = *(const u32x4*)(p3 + (k - 3) * rs); }
    float x[7][8];
#pragma unroll
    for (int k = 0; k < 7; ++k)
#pragma unroll
        for (int e = 0; e < 4; ++e) { x[k][2 * e] = bflo(raw[k][e]); x[k][2 * e + 1] = bfhi(raw[k][e]); }
#pragma unroll
    for (int r = 0; r < 4; ++r)
#pragma unroll
        for (int e = 0; e < 8; ++e) o[r][e] = silu_f(b[e] + w[0][e] * x[r][e] + w[1][e] * x[r + 1][e] + w[2][e] * x[r + 2][e] + w[3][e] * x[r + 3][e]);
}
DI void ssm_conv_w8(const float* cw, const float* cb, int ch, float (&w)[4][8], float (&b)[8]) {
#pragma unroll
    for (int k = 0; k < 4; ++k) { const f32x4 a0 = *(const f32x4*)(cw + k * XBC + ch), a1 = *(const f32x4*)(cw + k * XBC + ch + 4);
#pragma unroll
        for (int e = 0; e < 4; ++e) { w[k][e] = a0[e]; w[k][4 + e] = a1[e]; } }
    const f32x4 a0 = *(const f32x4*)(cb + ch), a1 = *(const f32x4*)(cb + ch + 4);
#pragma unroll
    for (int e = 0; e < 4; ++e) { b[e] = a0[e]; b[4 + e] = a1[e]; }
}
DI void ssd_dt_prep(const Ctx& c, int j, int row0, int g, LAS float* dtv, LAS float* acs, LAS float* tot) {
    const float* DT = (const float*)(c.ws + WS_DT);
    const int h = c.tid >> 7, l = c.tid & 127, head = g * 4 + h;
    const float dt = DT[(size_t)(row0 + l) * 32 + head];
    const float A = -__expf(inp(c, 5)[j * 32 + head]);
    float s = dt * A;
#pragma unroll
    for (int o = 1; o < 64; o <<= 1) { const float n = __shfl_up(s, o); if (c.lane >= o) s += n; }
    if (c.lane == 63) tot[c.wid] = s;
    dtv[h * 128 + l] = dt;
    __syncthreads();
    if (c.wid & 1) s += tot[c.wid - 1];
    acs[h * 128 + l] = s;
    __syncthreads();
}

DI int tsw(int row, int col) { return row * 136 + ((((col >> 3) ^ (row >> 3)) & 7) | ((col >> 3) & 8)) * 8 + (col & 7); }

DI void dt_proj_phase(const Ctx& c, const bf16_t* XN, const bf16_t* W1, float* DT, const float* dtb) {
    LAS float* part = (LAS float*)c.lds;
    const int r = c.lane & 31, hh = c.lane >> 5, rt = c.wid & 1, kq = c.wid >> 1;
    for (int blk = c.bid; blk < MROWS / 64; blk += gridDim.x) {
        const bf16_t* ap = XN + (size_t)(blk * 64 + rt * 32 + r) * DM + kq * 256 + 8 * hh;
        const bf16_t* bp = W1 + (size_t)(NPROJ + r) * DM + kq * 256 + 8 * hh;
        bf16x8 av[16], bv[16];
#pragma unroll
        for (int ks = 0; ks < 16; ++ks) { av[ks] = *(const bf16x8*)(ap + 16 * ks); bv[ks] = *(const bf16x8*)(bp + 16 * ks); }
        f32x16 acc;
#pragma unroll
        for (int e = 0; e < 16; ++e) acc[e] = 0.f;
#pragma unroll
        for (int ks = 0; ks < 16; ++ks) acc = MFMA32(av[ks], bv[ks], acc);
#pragma unroll
        for (int e = 0; e < 16; ++e) part[(c.wid * 16 + e) * 64 + c.lane] = acc[e];
        __syncthreads();
        if (kq == 0) {
#pragma unroll
            for (int e = 0; e < 16; ++e) { const float v = part[((rt) * 16 + e) * 64 + c.lane] + part[((rt + 2) * 16 + e) * 64 + c.lane] + part[((rt + 4) * 16 + e) * 64 + c.lane] + part[((rt + 6) * 16 + e) * 64 + c.lane];
                const float raw = v + dtb[r];
                DT[(size_t)(blk * 64 + rt * 32 + crow(e, hh)) * 32 + r] = raw > 20.0f ? raw : log1pf(__expf(raw)); }
        }
        __syncthreads();
    }
}

DI void ssd_states_phase(const Ctx& c, int j) {
    const bf16_t* proj = (const bf16_t*)(c.ws + WS_BIG); bf16_t* ST = (bf16_t*)(c.ws + WS_ST); float* CD = (float*)(c.ws + WS_CD);
    const float* cw = inp(c, 2) + (size_t)j * 4 * XBC; const float* cb = inp(c, 3) + (size_t)j * XBC;
    LAS bf16_t* XT = (LAS bf16_t*)c.lds;
    LAS bf16_t* BT = XT + 256 * 136;
    LAS float* dtv = (LAS float*)(BT + 128 * 136);
    LAS float* acs = dtv + 512; LAS float* wgt = acs + 512; LAS float* tot = wgt + 512;
    const int r = c.lane & 31, hh = c.lane >> 5;
    for (int item = c.bid; item < 1024; item += gridDim.x) {
        const int b = item >> 8, ci = (item >> 3) & 31, g = item & 7, row0 = b * SEQ + ci * 128, t0 = ci * 128;
        ssd_dt_prep(c, j, row0, g, dtv, acs, tot);
        { const int h = c.tid >> 7, l = c.tid & 127; const float last = acs[h * 128 + 127], s = acs[h * 128 + l];
          wgt[h * 128 + l] = dtv[h * 128 + l] * __expf(last - s);
          if (l == 127) CD[(b * 32 + ci) * 32 + g * 4 + h] = __expf(s); }
        __syncthreads();
        {
            const int chunk = c.tid & 31, ch = g * 256 + chunk * 8, h = chunk >> 3; float w[4][8], bb[8]; ssm_conv_w8(cw, cb, ch, w, bb);
#pragma unroll
            for (int it = 0; it < 2; ++it) { const int l = 4 * ((c.tid >> 5) + 16 * it); float o[4][8]; ssm_conv_run4(proj, row0 + l, t0 + l, ch, w, bb, o);
                const f32x4 sc = *(const LAS f32x4*)(wgt + h * 128 + l);
#pragma unroll
                for (int e = 0; e < 8; ++e) { u32x2 v; v.x = cvtpk(o[0][e] * sc[0], o[1][e] * sc[1]); v.y = cvtpk(o[2][e] * sc[2], o[3][e] * sc[3]); *(LAS u32x2*)(XT + tsw(chunk * 8 + e, l)) = v; } }
        }
        {
            const int chunk = c.tid & 15, ch = DIN + g * 128 + chunk * 8, l = 4 * (c.tid >> 4); float w[4][8], bb[8]; ssm_conv_w8(cw, cb, ch, w, bb);
            float o[4][8]; ssm_conv_run4(proj, row0 + l, t0 + l, ch, w, bb, o);
#pragma unroll
            for (int e = 0; e < 8; ++e) { u32x2 v; v.x = cvtpk(o[0][e], o[1][e]); v.y = cvtpk(o[2][e], o[3][e]); *(LAS u32x2*)(BT + tsw(chunk * 8 + e, l)) = v; }
        }
        __syncthreads();
        {
            const int h = c.wid >> 1, pt = c.wid & 1; f32x16 acc[4];
#pragma unroll
            for (int nt = 0; nt < 4; ++nt)
#pragma unroll
                for (int e = 0; e < 16; ++e) acc[nt][e] = 0.f;
#pragma unroll
            for (int ks = 0; ks < 8; ++ks) { const bf16x8 bop = *(const LAS bf16x8*)(XT + tsw(h * 64 + pt * 32 + r, 16 * ks + 8 * hh));
#pragma unroll
                for (int nt = 0; nt < 4; ++nt) { const bf16x8 a = *(const LAS bf16x8*)(BT + tsw(nt * 32 + r, 16 * ks + 8 * hh)); acc[nt] = MFMA32(a, bop, acc[nt]); } }
            bf16_t* dst = ST + (size_t)((b * 32 + ci) * 32 + g * 4 + h) * 8192;
#pragma unroll
            for (int nt = 0; nt < 4; ++nt)
#pragma unroll
                for (int q = 0; q < 4; ++q) { u32x2 o; o.x = cvtpk(acc[nt][4 * q], acc[nt][4 * q + 1]); o.y = cvtpk(acc[nt][4 * q + 2], acc[nt][4 * q + 3]); *(u32x2*)(dst + (((pt * 8 + nt * 2 + (q >> 1)) * 64 + (q & 1) * 32 + r) * 8 + 4 * hh)) = o; }
        }
        __syncthreads();
    }
}

DI void ssd_scan_phase(const Ctx& c) {
    bf16_t* ST = (bf16_t*)(c.ws + WS_ST); const float* CD = (const float*)(c.ws + WS_CD);
    for (int idx = c.bid * 512 + c.tid; idx < 4 * 32 * 1024; idx += gridDim.x * 512) {
        const int e8 = idx & 1023, head = (idx >> 10) & 31, b = idx >> 15; float carry[8];
#pragma unroll
        for (int e = 0; e < 8; ++e) carry[e] = 0.f;
#pragma unroll 16
        for (int ci = 0; ci < 32; ++ci) { u32x4* p = (u32x4*)(ST + ((size_t)((b * 32 + ci) * 32 + head) * 8192 + e8 * 8)); const u32x4 s = *p; const float dec = CD[(b * 32 + ci) * 32 + head];
            u32x4 o; o.x = cvtpk(carry[0], carry[1]); o.y = cvtpk(carry[2], carry[3]); o.z = cvtpk(carry[4], carry[5]); o.w = cvtpk(carry[6], carry[7]); *p = o;
#pragma unroll
            for (int e = 0; e < 4; ++e) { carry[2 * e] = carry[2 * e] * dec + bflo(s[e]); carry[2 * e + 1] = carry[2 * e + 1] * dec + bfhi(s[e]); } }
    }
}

DI void ssd_out_phase(const Ctx& c, int j) {
    const bf16_t* proj = (const bf16_t*)(c.ws + WS_BIG); const bf16_t* ST = (const bf16_t*)(c.ws + WS_ST); bf16_t* Y = (bf16_t*)(c.ws + WS_Y);
    const float* cw = inp(c, 2) + (size_t)j * 4 * XBC; const float* cb = inp(c, 3) + (size_t)j * XBC;
    LAS bf16_t* Cn = (LAS bf16_t*)c.lds;
    LAS bf16_t* Bn = Cn + 128 * 136;
    LAS bf16_t* XT = Bn + 128 * 136;
    LAS float* dtv = (LAS float*)(XT + 256 * 136);
    LAS float* acs = dtv + 512; LAS float* tot = acs + 512; LAS float* red = tot + 8;
    const int r = c.lane & 31, hh = c.lane >> 5, h = c.wid >> 1, ph = c.wid & 1;
    for (int item = c.bid; item < 1024; item += gridDim.x) {
        const int b = item >> 8, ci = (item >> 3) & 31, g = item & 7, row0 = b * SEQ + ci * 128, t0 = ci * 128, head = g * 4 + h;
        bf16x8 pvf[8];
        { const bf16_t* src = ST + (size_t)((b * 32 + ci) * 32 + head) * 8192 + ((ph * 8) * 64 + hh * 32 + r) * 8;
#pragma unroll
          for (int ks = 0; ks < 8; ++ks) pvf[ks] = *(const bf16x8*)(src + ks * 512); }
        ssd_dt_prep(c, j, row0, g, dtv, acs, tot);
        {
            const int chunk = c.tid & 15, l = 4 * (c.tid >> 4);
            { const int ch = DIN + g * 128 + chunk * 8; float w[4][8], bb[8]; ssm_conv_w8(cw, cb, ch, w, bb); float o[4][8]; ssm_conv_run4(proj, row0 + l, t0 + l, ch, w, bb, o);
#pragma unroll
              for (int rr = 0; rr < 4; ++rr) { u32x4 v; v.x = cvtpk(o[rr][0], o[rr][1]); v.y = cvtpk(o[rr][2], o[rr][3]); v.z = cvtpk(o[rr][4], o[rr][5]); v.w = cvtpk(o[rr][6], o[rr][7]); *(LAS u32x4*)(Bn + (l + rr) * 136 + chunk * 8) = v; } }
            { const int ch = DIN + 1024 + g * 128 + chunk * 8; float w[4][8], bb[8]; ssm_conv_w8(cw, cb, ch, w, bb); float o[4][8]; ssm_conv_run4(proj, row0 + l, t0 + l, ch, w, bb, o);
#pragma unroll
              for (int rr = 0; rr < 4; ++rr) { u32x4 v; v.x = cvtpk(o[rr][0], o[rr][1]); v.y = cvtpk(o[rr][2], o[rr][3]); v.z = cvtpk(o[rr][4], o[rr][5]); v.w = cvtpk(o[rr][6], o[rr][7]); *(LAS u32x4*)(Cn + (l + rr) * 136 + chunk * 8) = v; } }
        }
        {
            const int chunk = c.tid & 31, ch = g * 256 + chunk * 8; float w[4][8], bb[8]; ssm_conv_w8(cw, cb, ch, w, bb);
#pragma unroll
            for (int it = 0; it < 2; ++it) { const int l = 4 * ((c.tid >> 5) + 16 * it); float o[4][8]; ssm_conv_run4(proj, row0 + l, t0 + l, ch, w, bb, o);
#pragma unroll
                for (int e = 0; e < 8; ++e) { u32x2 v; v.x = cvtpk(o[0][e], o[1][e]); v.y = cvtpk(o[2][e], o[3][e]); *(LAS u32x2*)(XT + tsw(chunk * 8 + e, l)) = v; } }
        }
        __syncthreads();
        const float Dh = inp(c, 6)[j * 32 + head];
#pragma unroll 1
        for (int lb = 0; lb < 4; ++lb) {
            const int l = lb * 32 + r; f32x16 accl;
            u32x2 zz[4];
#pragma unroll
            for (int q = 0; q < 4; ++q) zz[q] = *(const u32x2*)(proj + pblk(row0, g * 256 + h * 64 + ph * 32) + (unsigned)(l * 256 + 8 * q + 4 * hh));
#pragma unroll
            for (int e = 0; e < 16; ++e) accl[e] = 0.f;
#pragma unroll
            for (int ks = 0; ks < 8; ++ks) { const bf16x8 bop = *(const LAS bf16x8*)(Cn + l * 136 + 16 * ks + 8 * hh); accl = MFMA32(pvf[ks], bop, accl); }
            const float al = acs[h * 128 + l]; const float eal = __expf(al);
#pragma unroll
            for (int e = 0; e < 16; ++e) accl[e] *= eal;
#pragma unroll 1
            for (int sb = 0; sb <= lb; ++sb) {
                f32x16 cbt;
#pragma unroll
                for (int e = 0; e < 16; ++e) cbt[e] = 0.f;
#pragma unroll
                for (int ks = 0; ks < 8; ++ks) { const bf16x8 a = *(const LAS bf16x8*)(Bn + (sb * 32 + r) * 136 + 16 * ks + 8 * hh); const bf16x8 bop = *(const LAS bf16x8*)(Cn + l * 136 + 16 * ks + 8 * hh);
                    cbt = MFMA32(a, bop, cbt); }
                f32x4 av[4], dv[4];
#pragma unroll
                for (int q = 0; q < 4; ++q) { av[q] = *(const LAS f32x4*)(acs + h * 128 + sb * 32 + 8 * q + 4 * hh); dv[q] = *(const LAS f32x4*)(dtv + h * 128 + sb * 32 + 8 * q + 4 * hh); }
#pragma unroll
                for (int ss = 0; ss < 2; ++ss) {
                    float v[8];
#pragma unroll
                    for (int jj = 0; jj < 8; ++jj) { const int i = 8 * ss + jj, s = sb * 32 + crow(i, hh); const float e = (sb < lb || s <= l) ? __expf(al - av[i >> 2][i & 3]) * dv[i >> 2][i & 3] : 0.f;
                        v[jj] = cbt[i] * e + ((s == l) ? Dh : 0.f); }
                    u32x4 pk; pk.x = cvtpk(v[0], v[1]); pk.y = cvtpk(v[2], v[3]); pk.z = cvtpk(v[4], v[5]); pk.w = cvtpk(v[6], v[7]);
                    const bf16x8 bop = __builtin_bit_cast(bf16x8, pk);
                    const int xrow = h * 64 + ph * 32 + r, xcol = sb * 32 + 16 * ss + 4 * hh;
                    const s16x4 lo = *(const LAS s16x4*)(XT + tsw(xrow, xcol)), hi = *(const LAS s16x4*)(XT + tsw(xrow, xcol + 8));
                    const bf16x8 a = __builtin_shufflevector(lo, hi, 0, 1, 2, 3, 4, 5, 6, 7);
                    accl = MFMA32(a, bop, accl);
                }
            }
            float sq = 0.f;
#pragma unroll
            for (int q = 0; q < 4; ++q) {
                const float zf[4] = {bflo(zz[q].x), bfhi(zz[q].x), bflo(zz[q].y), bfhi(zz[q].y)};
#pragma unroll
                for (int e = 0; e < 4; ++e) { const float yv = accl[4 * q + e] * zf[e]; accl[4 * q + e] = yv; sq += yv * yv; }
            }
            sq += __shfl_xor(sq, 32);
            LAS float* redb = red + (lb & 1) * 256;
            if (hh == 0) redb[c.wid * 32 + r] = sq;
            __syncthreads();
            float tsum = 0.f;
#pragma unroll
            for (int w8 = 0; w8 < 8; ++w8) tsum += redb[w8 * 32 + r];
            const float rstd = rsqrtf(tsum * (1.0f / 256.0f) + EPS);
#pragma unroll
            for (int q = 0; q < 4; ++q) { u32x2 o; o.x = cvtpk(accl[4 * q] * rstd, accl[4 * q + 1] * rstd); o.y = cvtpk(accl[4 * q + 2] * rstd, accl[4 * q + 3] * rstd);
                *(u32x2*)(Y + (size_t)(row0 + l) * DIN + g * 256 + h * 64 + ph * 32 + 8 * q + 4 * hh) = o; }
        }
        __syncthreads();
    }
}

DI void attn_load_tile(const bf16_t* KVB, int b, int h, int t, int kt, int tid, u32x4& kreg, u32x4 (&vreg)[2]) {
    const bf16_t* kb = KVB + ((size_t)(((b * 8 + h) * 2 + t) * 4096 + kt * 64)) * 64;
    const bf16_t* vb = KVB + (size_t)4 * 8 * 2 * 4096 * 64 + ((size_t)((b * 8 + h) * 4096 + kt * 64)) * 128;
    kreg = *(const u32x4*)(kb + (unsigned)tid * 8u);
#pragma unroll
    for (int kk = 0; kk < 2; ++kk) vreg[kk] = *(const u32x4*)(vb + (unsigned)tid * 8u + kk * 4096);
}
DI void attn_store_tile(LAS bf16_t* Kn, LAS bf16_t* Vn, int tid, const u32x4& kreg, const u32x4 (&vreg)[2]) {
    *(LAS u32x4*)(Kn + (tid >> 3) * 72 + 8 * (tid & 7)) = kreg;
#pragma unroll
    for (int kk = 0; kk < 2; ++kk) *(LAS u32x4*)(Vn + ((tid >> 4) + 32 * kk) * 160 + 8 * (tid & 15)) = vreg[kk];
}
typedef short v4i16_t __attribute__((ext_vector_type(4)));
DI s16x4 vtr(const LAS bf16_t* p) { return __builtin_bit_cast(s16x4, __builtin_amdgcn_ds_read_tr16_b64_v4i16((LAS v4i16_t*)p)); }
DI void attn_tile(const LAS bf16_t* Kn, const LAS bf16_t* Vt, const bf16x8 (&Qf)[4], int tidv, int kv0, int q0w, int qpos, float c2, float& m, float& lsum, f32x16 (&O)[4]) {
    if (kv0 > q0w + 31) return;
    const int r = tidv & 31, hh = (tidv >> 5) & 1;
    const LAS bf16_t* vbase = Vt + (4 * hh + ((tidv & 15) >> 2)) * 160 + 16 * ((tidv >> 4) & 1) + 4 * (tidv & 3);
    f32x16 st[2];
#pragma unroll
    for (int kb = 0; kb < 2; ++kb)
#pragma unroll
        for (int e = 0; e < 16; ++e) st[kb][e] = 0.f;
#pragma unroll
    for (int ks = 0; ks < 4; ++ks) {
        const bf16x8 qf = Qf[ks];
#pragma unroll
        for (int kb = 0; kb < 2; ++kb) { const bf16x8 a = *(const LAS bf16x8*)(Kn + (kb * 32 + r) * 72 + 16 * ks + 8 * hh); st[kb] = MFMA32(a, qf, st[kb]); }
    }
    const float fb = (float)(kv0 + 4 * hh - qpos);
#pragma unroll
    for (int kb = 0; kb < 2; ++kb)
#pragma unroll
        for (int e = 0; e < 16; ++e) st[kb][e] = fmaf(c2, fb + (float)(kb * 32 + 8 * (e >> 2) + (e & 3)), st[kb][e]);
    if (kv0 + 63 > q0w) {
#pragma unroll
        for (int kb = 0; kb < 2; ++kb)
#pragma unroll
            for (int e = 0; e < 16; ++e) { const int kpos = kv0 + kb * 32 + crow(e, hh); if (kpos > qpos) st[kb][e] = -INFINITY; }
    }
    float mx = __builtin_fmaxf(st[0][0], st[1][0]);
#pragma unroll
    for (int e = 1; e < 16; ++e) mx = __builtin_fmaxf(__builtin_fmaxf(mx, st[0][e]), st[1][e]);
    { const auto sw = __builtin_amdgcn_permlane32_swap(__float_as_uint(mx), __float_as_uint(mx), false, false); mx = fmaxf(__uint_as_float(sw[0]), __uint_as_float(sw[1])); }
    const float mn = fmaxf(m, mx), alpha = __builtin_amdgcn_exp2f(m - mn); m = mn;
    f32x2_t ps2 = {0.f, 0.f};
#pragma unroll
    for (int kb = 0; kb < 2; ++kb)
#pragma unroll
        for (int e = 0; e < 16; e += 2) { const float p0 = __builtin_amdgcn_exp2f(st[kb][e] - mn), p1 = __builtin_amdgcn_exp2f(st[kb][e + 1] - mn); st[kb][e] = p0; st[kb][e + 1] = p1; ps2 += (f32x2_t){p0, p1}; }
    lsum = lsum * alpha + (ps2.x + ps2.y);
    if (__builtin_amdgcn_ballot_w64(alpha != 1.0f) != 0ull) {
#pragma unroll
        for (int et = 0; et < 4; ++et)
#pragma unroll
            for (int e = 0; e < 16; ++e) O[et][e] *= alpha;
    }
#pragma unroll
    for (int kb = 0; kb < 2; ++kb)
#pragma unroll
        for (int ss = 0; ss < 2; ++ss) {
            u32x4 pk; pk.x = cvtpk(st[kb][8 * ss], st[kb][8 * ss + 1]); pk.y = cvtpk(st[kb][8 * ss + 2], st[kb][8 * ss + 3]); pk.z = cvtpk(st[kb][8 * ss + 4], st[kb][8 * ss + 5]); pk.w = cvtpk(st[kb][8 * ss + 6], st[kb][8 * ss + 7]);
            const bf16x8 bop = __builtin_bit_cast(bf16x8, pk);
#pragma unroll
            for (int et = 0; et < 4; ++et) { const LAS bf16_t* vp = vbase + (kb * 32 + 16 * ss) * 160 + et * 32; const s16x4 lo = vtr(vp), hi = vtr(vp + 8 * 160);
                const bf16x8 a = __builtin_shufflevector(lo, hi, 0, 1, 2, 3, 4, 5, 6, 7); O[et] = MFMA32(a, bop, O[et]); }
        }
}
DI void attn_phase(const Ctx& c, int i) {
    const int j = i >> 1;
    const bf16_t* QKV = (const bf16_t*)(c.ws + WS_BIG); const bf16_t* KVB = (const bf16_t*)(c.ws + WS_KVB); bf16_t* AO = (bf16_t*)(c.ws + WS_Y);
    LAS bf16_t* KV0 = (LAS bf16_t*)c.lds;
#define KNB(bb) (KV0 + (bb) * 14848)
#define VTB(bb) (KV0 + (bb) * 14848 + 64 * 72)
    const int r = c.lane & 31, hh = c.lane >> 5;
    for (int up = c.bid; up < 256; up += gridDim.x) {
        const int bh = up >> 3, qsel = up & 7, b = bh >> 3, h = bh & 7;
        const float c2 = exp2f(-(float)(h + 1)) * LOG2E;
#pragma unroll 1
        for (int which = 0; which < 2; ++which) {
            const int qb = which ? qsel : 15 - qsel, q0w = qb * 256 + c.wid * 32, qpos = q0w + r, ntile = 4 * (qb + 1);
            const bf16_t* qbase = QKV + (size_t)(b * SEQ + q0w) * NQKV + h * 128;
            bf16_t* obase = AO + (size_t)(b * SEQ + q0w) * DM + h * 128;
            LAS unsigned* O1S = (LAS unsigned*)(KV0 + 2 * 14848) + c.wid * 32 * 64;

#pragma unroll 1
            for (int t = 0; t < 2; ++t) {
                bf16x8 Qf[4];
                { int tq = c.tid; asm volatile("" : "+v"(tq)); const unsigned qoff = (unsigned)((tq & 31) * NQKV + 8 * ((tq >> 5) & 1));
#pragma unroll
                  for (int ks = 0; ks < 4; ++ks) Qf[ks] = *(const bf16x8*)(qbase + t * 64 + 16 * ks + qoff); }
                f32x16 O[4];
#pragma unroll
                for (int et = 0; et < 4; ++et)
#pragma unroll
                    for (int e = 0; e < 16; ++e) O[et][e] = 0.f;
                float m = -1e30f, lsum = 0.f;
                u32x4 kregA, vregA[2], kregB, vregB[2];
                attn_load_tile(KVB, b, h, t, 0, c.tid, kregA, vregA);
                attn_load_tile(KVB, b, h, t, 1, c.tid, kregB, vregB);
                attn_store_tile(KNB(0), VTB(0), c.tid, kregA, vregA);
                __syncthreads();
#pragma unroll 1
                for (int kt = 0; kt < ntile; kt += 2) {
                    int tidv = c.tid; asm volatile("" : "+v"(tidv));
                    if (kt + 2 < ntile) attn_load_tile(KVB, b, h, t, kt + 2, tidv, kregA, vregA);
                    attn_tile(KNB(0), VTB(0), Qf, tidv, kt * 64, q0w, qpos, c2, m, lsum, O);
                    attn_store_tile(KNB(1), VTB(1), tidv, kregB, vregB);
                    __syncthreads();
                    asm volatile("" : "+v"(tidv));
                    if (kt + 3 < ntile) attn_load_tile(KVB, b, h, t, kt + 3, tidv, kregB, vregB);
                    attn_tile(KNB(1), VTB(1), Qf, tidv, kt * 64 + 64, q0w, qpos, c2, m, lsum, O);
                    if (kt + 2 < ntile) attn_store_tile(KNB(0), VTB(0), tidv, kregA, vregA);
                    __syncthreads();
                }
                lsum += __shfl_xor(lsum, 32);
                const float inv = 1.0f / lsum;
                int te = c.tid; asm volatile("" : "+v"(te));
                const unsigned o1off = (unsigned)(te & 63), aoff = (unsigned)((te & 31) * DM + 4 * ((te >> 5) & 1));
                if (t == 0) {
#pragma unroll
                    for (int et = 0; et < 4; ++et)
#pragma unroll
                        for (int q = 0; q < 4; ++q) { O1S[((et * 4 + q) * 2) * 64 + o1off] = cvtpk(O[et][4 * q] * inv, O[et][4 * q + 1] * inv); O1S[((et * 4 + q) * 2 + 1) * 64 + o1off] = cvtpk(O[et][4 * q + 2] * inv, O[et][4 * q + 3] * inv); }
                } else {
                    float s1 = 0.f, s2 = 0.f;
                    { const float* lq1 = inp(c, 10) + j * 64; const float* lk1 = inp(c, 11) + j * 64; const float* lq2 = inp(c, 12) + j * 64; const float* lk2 = inp(c, 13) + j * 64;
#pragma unroll 4
                      for (int d = 0; d < 64; ++d) { s1 += lq1[d] * lk1[d]; s2 += lq2[d] * lk2[d]; } }
                    const float lam = __expf(s1) - __expf(s2) + lambda_init(i);
                    float ssq = 0.f; const float li = lam * inv;
#pragma unroll
                    for (int et = 0; et < 4; ++et)
#pragma unroll
                        for (int q = 0; q < 4; ++q) { const unsigned w0 = O1S[((et * 4 + q) * 2) * 64 + o1off], w1 = O1S[((et * 4 + q) * 2 + 1) * 64 + o1off]; const f32x4 o1 = (f32x4){bflo(w0), bfhi(w0), bflo(w1), bfhi(w1)};
#pragma unroll
                            for (int e = 0; e < 4; ++e) { const float v = o1[e] - li * O[et][4 * q + e]; O[et][4 * q + e] = v; ssq += v * v; } asm volatile("" ::: "memory"); }
                    ssq += __shfl_xor(ssq, 32);
                    const float rstd = rsqrtf(ssq * (1.0f / 128.0f) + EPS);
#pragma unroll
                    for (int et = 0; et < 4; ++et)
#pragma unroll
                        for (int q = 0; q < 4; ++q) { u32x2 o; o.x = cvtpk(O[et][4 * q] * rstd, O[et][4 * q + 1] * rstd); o.y = cvtpk(O[et][4 * q + 2] * rstd, O[et][4 * q + 3] * rstd);
                            *(u32x2*)(obase + et * 32 + 8 * q + aoff) = o; asm volatile("" ::: "memory"); }
                }
            }
        }
    }
}

#define XB_TMO      128
#define XB_XCNT(j)  (256  + 64 * (j))
#define XB_XSUB(j)  (1280 + 64 * (j))
#define XB_XGEN(j)  (2304 + 64 * (j))
#define XB_TOP      3328
#define XB_TOPGEN   3392
#define XCD_BAR_WORDS 3456
#define XB_SPIN_CAP (1u << 18)

__device__ __forceinline__ unsigned xb_ld(unsigned* p)              { return __hip_atomic_load(p, __ATOMIC_RELAXED, __HIP_MEMORY_SCOPE_AGENT); }
__device__ __forceinline__ unsigned xb_add(unsigned* p, unsigned v) { return __hip_atomic_fetch_add(p, v, __ATOMIC_RELAXED, __HIP_MEMORY_SCOPE_AGENT); }
__device__ __forceinline__ unsigned xb_xcc_id() { return (unsigned)__builtin_amdgcn_s_getreg((3 << 11) | 20) & 0xFu; }
#define XB_SPIN(cond, bar) do { unsigned _sp = 0; while (cond) { __builtin_amdgcn_s_sleep(1); \
    if ((++_sp & 255u) == 0u) { if (xb_ld(&(bar)[XB_TMO])) break; if (_sp > XB_SPIN_CAP) { atomicAdd(&(bar)[XB_TMO], 1u); break; } } } } while (0)

struct XcdBarrier {
    unsigned* bar; unsigned x;
    volatile LAS unsigned* st;
};

__device__ __forceinline__ XcdBarrier xcd_barrier_post(unsigned* bar, volatile LAS unsigned* st) {
    XcdBarrier b; b.bar = bar; b.x = xb_xcc_id(); b.st = st;
    if (threadIdx.x == 0) (void)xb_add(&bar[XB_XCNT(b.x)], 1u);
    return b;
}
__device__ __forceinline__ void xcd_barrier_complete(unsigned* bar, unsigned x, unsigned& nloc, unsigned& nx) {
    const unsigned G = gridDim.x * gridDim.y * gridDim.z;
    unsigned sum, cnt, mine, sp = 0u;
    for (;;) {
        sum = 0u; cnt = 0u; mine = 0u;
#pragma unroll
        for (unsigned j = 0; j < 16; ++j) { const unsigned c = xb_ld(&bar[XB_XCNT(j)]); sum += c; cnt += (c > 0u) ? 1u : 0u; mine = (j == x) ? c : mine; }
        if (sum == G) break;
        __builtin_amdgcn_s_sleep(1);
        if ((++sp & 255u) == 0u) { if (xb_ld(&bar[XB_TMO])) break; if (sp > XB_SPIN_CAP) { atomicAdd(&bar[XB_TMO], 1u); break; } }
    }
    nloc = mine > 0u ? mine : 1u; nx = cnt > 0u ? cnt : 1u;
}

__device__ __forceinline__ void xcd_barrier(const XcdBarrier& b) {
    asm volatile("s_waitcnt vmcnt(0)" ::: "memory");
    __syncthreads();
    if (threadIdx.x == 0) {
        unsigned* bar = b.bar;
        __builtin_amdgcn_s_waitcnt(0);
        unsigned nloc = b.st[0], nx = b.st[1];
        if (nloc == 0u) { xcd_barrier_complete(bar, b.x, nloc, nx); b.st[0] = nloc; b.st[1] = nx; }
        const unsigned old = xb_add(&bar[XB_XSUB(b.x)], 1u);
        const unsigned gen = old / nloc;
        if (old + 1u == (gen + 1u) * nloc) {
            __builtin_amdgcn_fence(__ATOMIC_RELEASE, "agent");
            asm volatile("s_waitcnt vmcnt(0)" ::: "memory");
            const unsigned og = xb_add(&bar[XB_TOP], 1u);
            const unsigned tg = og / nx;
            if (og + 1u == (tg + 1u) * nx) xb_add(&bar[XB_TOPGEN], 1u);
            else XB_SPIN(xb_ld(&bar[XB_TOPGEN]) == tg, bar);
            __builtin_amdgcn_fence(__ATOMIC_ACQUIRE, "agent");
            xb_add(&bar[XB_XGEN(b.x)], 1u);
            asm volatile("s_waitcnt vmcnt(0)" ::: "memory");
        } else {
            XB_SPIN(xb_ld(&bar[XB_XGEN(b.x)]) == gen, bar);
            __builtin_amdgcn_fence(__ATOMIC_ACQUIRE, "agent");
            asm volatile("s_waitcnt vmcnt(0)" ::: "memory");
        }
    }
    __syncthreads();
}


struct Args { const float* in[24]; float* out; unsigned char* ws; };
__global__ void __launch_bounds__(512, 2) hybrid_fwd(Args a) {
    extern __shared__ __attribute__((aligned(16))) unsigned char lds_raw[];
    cg::grid_group grid = cg::this_grid();
    Ctx c;
    c.out = a.out; c.ws = a.ws; c.lds = (LAS unsigned char*)lds_raw;
    if (threadIdx.x == 0) {
#pragma unroll
        for (int k = 0; k < 24; ++k) ((LAS unsigned long long*)(c.lds + PTR_OFF))[k] = (unsigned long long)a.in[k];
        ((LAS unsigned*)(c.lds + PTR_OFF + 192))[0] = 0u; ((LAS unsigned*)(c.lds + PTR_OFF + 192))[1] = 0u;
    }
    unsigned* barw = (unsigned*)(c.ws + WS_BAR);
    if (blockIdx.x == 0) for (int k = threadIdx.x; k < XCD_BAR_WORDS; k += 512) __hip_atomic_store(barw + k, 0u, __ATOMIC_RELAXED, __HIP_MEMORY_SCOPE_AGENT);
    __syncthreads();
    c.ngw = gridDim.x * 8;
#define REFRESH() do { int t_ = threadIdx.x; asm volatile("" : "+v"(t_)); int b_ = blockIdx.x; asm volatile("" : "+s"(b_)); c.tid = t_; c.lane = t_ & 63; \
        c.wid = __builtin_amdgcn_readfirstlane(t_ >> 6); c.bid = b_; c.gw = b_ * 8 + c.wid; } while (0)
    REFRESH();
    bf16_t* W1 = (bf16_t*)(c.ws + WS_W1); bf16_t* W2 = (bf16_t*)(c.ws + WS_W2); bf16_t* XN = (bf16_t*)(c.ws + WS_XN); bf16_t* Mb = (bf16_t*)(c.ws + WS_M);
    bf16_t* BIG = (bf16_t*)(c.ws + WS_BIG); bf16_t* ACT = (bf16_t*)(c.ws + WS_ACT); bf16_t* Yb = (bf16_t*)(c.ws + WS_Y); float* DT = (float*)(c.ws + WS_DT);

#ifdef PROBE_CAT
    unsigned long long tacc[8] = {0, 0, 0, 0, 0, 0, 0, 0}; unsigned long long tprev = __builtin_amdgcn_s_memrealtime();
#define TICK(cat) do { const unsigned long long tn_ = __builtin_amdgcn_s_memrealtime(); tacc[cat] += tn_ - tprev; tprev = tn_; } while (0)
#else
#define TICK(cat) do { } while (0)
#endif
    if (PMASK & 1) rowwise_phase(c, inp(c, 0), nullptr, nullptr, nullptr, nullptr, XN, false);
    REFRESH();
    if (PMASK & 2) convert_phase(c, 0, 0);
    TICK(5);
    grid.sync();
    const XcdBarrier xbar = xcd_barrier_post(barw, (volatile LAS unsigned*)(c.lds + PTR_OFF + 192));
#define GSYNC() xcd_barrier(xbar)
    TICK(7);
#pragma unroll 1
    for (int sl = 0; sl < 8; ++sl) {
        const int i = sl >> 1, j = i >> 1; const bool ffn = sl & 1, ssm = !(i & 1);
        REFRESH();
        if (PMASK & 4) {
            const int N = ffn ? NUP : (ssm ? NPROJ : NQKV), nmain = N;
            pg8::Gemm g{XN, W1, MROWS, N, DM, DM}; pg8::StaticOrder S; S.init(MROWS, N, (int)gridDim.x, c.bid);
            pg8::EpiStore E{BIG, nmain, nmain, nullptr, (!ffn && ssm) ? DIN : 0, (!ffn && !ssm) ? (bf16_t*)(c.ws + WS_KVB) : nullptr, (!ffn && ssm) ? 1 : 0};
            for (int rp = 0; rp < NREP(4); ++rp) pg8::gemm_phase<pg8::EpiStore, pg8::StaticOrder, false, true>(c.lds, g, S, E);
            if (!ffn && ssm) dt_proj_phase(c, XN, W1, DT, inp(c, 4) + j * 32);
        }
        TICK(0);
        GSYNC();
        TICK(7);
        REFRESH();
        if (ffn) { for (int rp = 0; rp < NREP(8); ++rp) ffn_gate_phase(c, i); TICK(4); }
        else if (ssm) { for (int rp = 0; rp < NREP(16); ++rp) ssd_states_phase(c, j); TICK(2); GSYNC(); TICK(7); REFRESH(); if (PMASK & 32) ssd_scan_phase(c); TICK(6); GSYNC(); TICK(7); REFRESH(); for (int rp = 0; rp < NREP(64); ++rp) ssd_out_phase(c, j); TICK(3); }
        else { for (int rp = 0; rp < NREP(128); ++rp) attn_phase(c, i); TICK(1); }
        if (DUP & 256) { for (int rp = 0; rp < 4; ++rp) GSYNC(); }
        GSYNC();
        TICK(7);
        REFRESH();
        if (PMASK & 4) {
            const int K = ffn ? DFF : (ssm ? DIN : DM); const bf16_t* A = ffn ? ACT : Yb;
            pg8::Gemm g{A, W2, MROWS, DM, K, K}; pg8::StaticOrder S; S.init(MROWS, DM, (int)gridDim.x, c.bid);
            pg8::EpiStore E{Mb, DM, DM, nullptr, 0, nullptr, 0};
            for (int rp = 0; rp < NREP(512); ++rp) pg8::gemm_phase<pg8::EpiStore, pg8::StaticOrder, true, true>(c.lds, g, S, E);
        }
        TICK(0);
        GSYNC();
        TICK(7);
        REFRESH();
        if (PMASK & 1) rowwise_phase(c, nullptr, Mb, (ffn ? inp(c, 19) : inp(c, 17)) + i * DM, (sl == 0) ? inp(c, 0) : (const float*)c.out, c.out, XN, sl == 7);
        REFRESH();
        if (PMASK & 2) { if (!ffn) convert_phase(c, 2, i);
        else if (i < 3) convert_phase(c, ((i + 1) & 1) ? 1 : 0, i + 1); }
        TICK(5);
        if (sl < 7) { GSYNC(); TICK(7); }
    }
#ifdef PROBE_CAT
    if (blockIdx.x == 0 && threadIdx.x == 0) c.out[0] = 10000.0f + (float)(tacc[PROBE_CAT] / 100ull);
#endif
}

extern "C" void kernel_launch(void* const* d_in, const int* in_sizes, int n_in, void* d_out, int out_size, void* d_ws, size_t ws_size, hipStream_t stream) {
    static int grid_blocks = 0;
    if (grid_blocks == 0) {
        if (n_in != 24 || in_sizes[0] != MROWS * DM || out_size != MROWS * DM || ws_size < WS_END) {
            fprintf(stderr, "kernel_launch: unexpected problem (n_in %d, in0 %d, out %d, ws %zu < %zu?); nothing launched\n", n_in, n_in > 0 ? in_sizes[0] : -1, out_size, ws_size, (size_t)WS_END); grid_blocks = -1; return; }
        int dev = 0, cus = 0, per_cu = 0;
        hipGetDevice(&dev); hipDeviceGetAttribute(&cus, hipDeviceAttributeMultiprocessorCount, dev);
        if (hipFuncSetAttribute((const void*)hybrid_fwd, hipFuncAttributeMaxDynamicSharedMemorySize, LDS_BYTES) != hipSuccess) { fprintf(stderr, "kernel_launch: hipFuncSetAttribute failed\n"); grid_blocks = -1; return; }
        if (hipOccupancyMaxActiveBlocksPerMultiprocessor(&per_cu, (const void*)hybrid_fwd, 512, LDS_BYTES) != hipSuccess || per_cu < 1) { fprintf(stderr, "kernel_launch: occupancy query says %d\n", per_cu); per_cu = 1; }
        (void)hipGetLastError();
        grid_blocks = cus * (per_cu > 1 ? 1 : per_cu);
    }
    if (grid_blocks < 0) return;
    Args a{};
    for (int k = 0; k < 24; ++k) a.in[k] = (const float*)d_in[k];
    a.out = (float*)d_out; a.ws = (unsigned char*)d_ws;
    void* args[] = {&a};
    hipError_t e = hipLaunchCooperativeKernel((const void*)hybrid_fwd, dim3(grid_blocks), dim3(512), args, LDS_BYTES, stream);
    if (e != hipSuccess) fprintf(stderr, "kernel_launch: cooperative launch failed: %s (grid %d)\n", hipGetErrorString(e), grid_blocks);
}
```

```cpp
#include <hip/hip_runtime.h>
#include <hip/hip_cooperative_groups.h>
#include <cstdio>
#include <cstdint>
namespace cg = cooperative_groups;
#ifndef PMASK
#define PMASK 0xff
#endif
#ifndef DUP
#define DUP 0
#endif
#define NREP(bit) ((DUP & (bit)) ? 2 : 1)
#ifndef SUB
#define SUB 0
#endif
#define SREP(bit) ((SUB & (bit)) ? 2 : 1)

#define DI __device__ __forceinline__
#define LAS __attribute__((address_space(3)))
typedef unsigned short bf16_t;
typedef short bf16x8 __attribute__((ext_vector_type(8)));
typedef short s16x4 __attribute__((ext_vector_type(4)));
typedef float f32x4 __attribute__((ext_vector_type(4)));
typedef float f32x16 __attribute__((ext_vector_type(16)));
typedef unsigned u32x4 __attribute__((ext_vector_type(4)));
typedef unsigned u32x2 __attribute__((ext_vector_type(2)));
typedef __bf16 bf16x2_t __attribute__((ext_vector_type(2)));
typedef float f32x2_t __attribute__((ext_vector_type(2)));

DI unsigned cvtpk(float lo, float hi) { f32x2_t v = {lo, hi}; bf16x2_t b = __builtin_convertvector(v, bf16x2_t); return __builtin_bit_cast(unsigned, b); }
DI float bflo(unsigned w) { return __uint_as_float(w << 16); }
DI float bfhi(unsigned w) { return __uint_as_float(w & 0xffff0000u); }
DI float bf1(bf16_t b) { return __uint_as_float((unsigned)b << 16); }
DI float silu_f(float x) { return x * __builtin_amdgcn_rcpf(1.0f + __expf(-x)); }
DI float wave_sum(float v) {
#pragma unroll
    for (int o = 1; o < 64; o <<= 1) v += __shfl_xor(v, o);
    return v;
}
DI int crow(int reg, int h) { return (reg & 3) + 8 * (reg >> 2) + 4 * h; }
#define MFMA32(a, b, c) __builtin_amdgcn_mfma_f32_32x32x16_bf16((a), (b), (c), 0, 0, 0)
#define LDS_WAIT() asm volatile("s_waitcnt lgkmcnt(0)" ::: "memory")

constexpr int NB = 4, SEQ = 4096, DM = 1024, MROWS = NB * SEQ;
constexpr int DIN = 2048, NPROJ = 6144, NIN = 6176, NINP = 6400, DFF = 2816, NUP = 5632, NQKV = 3072, XBC = 4096;
constexpr float EPS = 1e-6f;
constexpr float LOG2E = 1.4426950408889634f;
constexpr size_t MiB = 1u << 20;
constexpr size_t WS_CD = 0;
constexpr size_t WS_BAR = 64 * 1024;
constexpr size_t WS_DT = 1 * MiB;
constexpr size_t WS_W1 = 3 * MiB;
constexpr size_t WS_W2 = 16 * MiB;
constexpr size_t WS_XN = 22 * MiB;
constexpr size_t WS_M = 54 * MiB;
constexpr size_t WS_ST = 22 * MiB;
constexpr size_t WS_BIG = 86 * MiB;
constexpr size_t WS_KVB = 86 * MiB + 96 * MiB;
constexpr size_t WS_ACT = 262 * MiB;
constexpr size_t WS_Y = 278 * MiB;
constexpr size_t WS_END = 350 * MiB;
constexpr int LDS_BYTES = 155648;

namespace pg8 {
#define PG8_LAS __attribute__((address_space(3)))
constexpr int BM = 256, BK = 64, HALF = 128, HTB = HALF * BK * 2  , STAGE_BYTES = 8 * HTB, NXCD = 8, WGM = 8;

__host__ __device__ __forceinline__ int lds_byte(int r, int c) { const int st = (r >> 4) * 2 + (c >> 5), rr = r & 15, cc = c & 31, ob = rr * 64 + cc * 2; return st * 1024 + (ob ^ (((ob >> 9) & 1) << 5)); }
__host__ __device__ __forceinline__ void stage_rc(int b, int& R, int& C) { const int st = b / 1024, sb = b % 1024, swz = sb ^ (((sb >> 9) & 1) << 5); R = (st >> 1) * 16 + swz / 64; C = (st & 1) * 32 + (swz % 64) / 2; }
__host__ __device__ __forceinline__ int perm32(int rho) { const int n = rho >> 4, i = rho & 15; return 8 * (i >> 2) + 4 * n + (i & 3); }

struct Unit { int pm, pn; };
struct Gemm { const bf16_t* A; const bf16_t* Bt; int M, N, K, lda; };

struct StaticOrder {
    int nM, nN, nwg, G, c;
    __host__ __device__ void init(int M, int N, int G_, int c_) { nM = M / BM; nN = N / BM; nwg = nM * nN; G = G_; c = c_; }
    __host__ __device__ bool next(int i, Unit& u) const {
        const long L = (long)i * G + c; if (L >= nwg) return false;
        int wgid = (int)L; { const int q = nwg / NXCD, r = nwg % NXCD, xcd = wgid % NXCD, off = wgid / NXCD; wgid = (xcd < r ? xcd * (q + 1) : r * (q + 1) + (xcd - r) * q) + off; }
        const int nig = WGM * nN, gid = wgid / nig, fm = gid * WGM, gsz = (nM - fm) < WGM ? (nM - fm) : WGM;
        u.pm = fm + ((wgid % nig) % gsz); u.pn = (wgid % nig) / gsz; return true;
    }
    __device__ __forceinline__ void a_ready(const Unit&) const {}
    __device__ __forceinline__ void done(const Unit&) const {}
};

template <class Epi, class Sched, bool ALIGN_EPI = false, bool SP2 = false>
__device__ __forceinline__ void gemm_phase(PG8_LAS unsigned char* lds, const Gemm g, const Sched& S, const Epi& E) {
    int tid_ = threadIdx.x; asm volatile("" : "+v"(tid_));
    const int tid = tid_, wid = __builtin_amdgcn_readfirstlane(tid >> 6), lane = tid & 63, wr = wid >> 2, wc = wid & 3, fr = lane & 15, fq = lane >> 4;
    const int K = g.K, nt = K / BK;
    unsigned voffA[2], voffB[2];
#pragma unroll
    for (int i = 0; i < 2; ++i) { int R, C; stage_rc(tid * 16 + i * 8192, R, C); const int Rb = Epi::PERM ? ((R & ~31) + perm32(R & 31)) : R;
        voffA[i] = (unsigned)(R * g.lda + C) * 2u; voffB[i] = (unsigned)(Rb * K + C) * 2u; }
    const size_t kstep = (size_t)(BK * 2);
    const size_t hstep = (size_t)HALF * K * 2;
    const size_t tstep = 2 * hstep; const size_t hstepA = (size_t)HALF * g.lda * 2, tstepA = 2 * hstepA;
    const unsigned ldsw = (unsigned)wid * 1024u;
    const int aoff = lds_byte(wr * 64 + fr, fq * 8), boff = lds_byte(wc * 32 + fr, fq * 8);
#define PG8_SA(b, h) (((b) * 2 + (h)) * HTB)
#define PG8_SB(b, h) ((4 + (b) * 2 + (h)) * HTB)
#define PG8_STAGE(bufoff, gbase, voff) do { _Pragma("unroll") for (int _i = 0; _i < 2; ++_i) \
        __builtin_amdgcn_global_load_lds((const unsigned*)((const char*)(gbase) + (voff)[_i]), (PG8_LAS unsigned*)(lds + (bufoff) + ldsw + _i * 8192), 16, 0, 0); } while (0)
#define PG8_LDA(dst, b, h) do { _Pragma("unroll") for (int m = 0; m < 4; ++m) _Pragma("unroll") for (int k = 0; k < 2; ++k) dst[m][k] = *(const PG8_LAS bf16x8*)(lds + PG8_SA(b, h) + aoff + m * 2048 + k * 1024); } while (0)
#define PG8_LDB(dst, b, h) do { _Pragma("unroll") for (int n = 0; n < 2; ++n) _Pragma("unroll") for (int k = 0; k < 2; ++k) dst[n][k] = *(const PG8_LAS bf16x8*)(lds + PG8_SB(b, h) + boff + n * 2048 + k * 1024); } while (0)
#define PG8_MMA(ai, bj, At, Bt) do { __builtin_amdgcn_s_setprio(1); _Pragma("unroll") for (int m = 0; m < 4; ++m) _Pragma("unroll") for (int n = 0; n < 2; ++n) _Pragma("unroll") for (int k = 0; k < 2; ++k) \
        acc[ai][bj][m][n] = __builtin_amdgcn_mfma_f32_16x16x32_bf16(Bt[n][k], At[m][k], acc[ai][bj][m][n], 0, 0, 0); __builtin_amdgcn_s_setprio(0); } while (0)
#define PG8_WAIT_V(n) asm volatile("s_waitcnt vmcnt(" #n ")" ::: "memory")
#define PG8_WAIT_L(n) asm volatile("s_waitcnt lgkmcnt(" #n ")" ::: "memory")
#define PG8_BAR __builtin_amdgcn_s_barrier()
#define PG8_SCHED __builtin_amdgcn_sched_barrier(0)
    Unit cur, nxt; int ui = 0;
    if (!S.next(0, cur)) return;
    f32x4 acc[2][2][4][2];
#pragma unroll
    for (int a = 0; a < 2; ++a)
#pragma unroll
        for (int b = 0; b < 2; ++b)
#pragma unroll
            for (int m = 0; m < 4; ++m)
#pragma unroll
                for (int n = 0; n < 2; ++n) acc[a][b][m][n] = (f32x4){0.f, 0.f, 0.f, 0.f};
    bf16x8 At[4][2], B0[2][2], B1[2][2];
    const char* cA = (const char*)g.A + (size_t)cur.pm * tstepA; const char* cB = (const char*)g.Bt + (size_t)cur.pn * tstep;
    S.a_ready(cur);
    if constexpr (SP2) {
        PG8_STAGE(PG8_SB(0, 0), cB, voffB); PG8_STAGE(PG8_SB(0, 1), cB + hstep, voffB); PG8_STAGE(PG8_SA(0, 0), cA, voffA); PG8_STAGE(PG8_SA(0, 1), cA + hstepA, voffA);
        if (wr == 1) PG8_BAR;
        PG8_WAIT_V(2); PG8_BAR;
        PG8_STAGE(PG8_SB(1, 0), cB + kstep, voffB); PG8_STAGE(PG8_SA(1, 0), cA + kstep, voffA); PG8_STAGE(PG8_SB(1, 1), cB + hstep + kstep, voffB);
        PG8_WAIT_V(6); PG8_BAR;
    } else {
        PG8_STAGE(PG8_SB(0, 0), cB, voffB); PG8_STAGE(PG8_SA(0, 0), cA, voffA); PG8_STAGE(PG8_SB(0, 1), cB + hstep, voffB); PG8_STAGE(PG8_SA(0, 1), cA + hstepA, voffA);
        if (wr == 1) PG8_BAR;
        PG8_WAIT_V(4); PG8_BAR;
        PG8_STAGE(PG8_SB(1, 0), cB + kstep, voffB); PG8_STAGE(PG8_SA(1, 0), cA + kstep, voffA); PG8_STAGE(PG8_SB(1, 1), cB + hstep + kstep, voffB);
        PG8_WAIT_V(6); PG8_BAR;
    }
    for (;;) {
        const bool has_next = S.next(ui + 1, nxt);
        const char* nA = has_next ? (const char*)g.A + (size_t)nxt.pm * tstepA : cA; const char* nB = has_next ? (const char*)g.Bt + (size_t)nxt.pn * tstep : cB;
        for (int t = 0; t < nt; t += 2) {
            const bool last = (t == nt - 2);
            const char* a1 = cA + (size_t)(t + 1) * kstep;
            const char* a2 = last ? nA : cA + (size_t)(t + 2) * kstep; const char* b2 = last ? nB : cB + (size_t)(t + 2) * kstep;
            const char* a3 = a2 + kstep; const char* b3 = b2 + kstep;
            if (last && has_next) S.a_ready(nxt);
            if constexpr (SP2) {
            PG8_LDB(B0, 0, 0); PG8_LDB(B1, 0, 1); PG8_SCHED; PG8_LDA(At, 0, 0); PG8_STAGE(PG8_SA(1, 1), a1 + hstepA, voffA);
            PG8_WAIT_V(8); PG8_WAIT_L(0); PG8_BAR; PG8_MMA(0, 0, At, B0); PG8_MMA(0, 1, At, B1); PG8_BAR; PG8_SCHED;
            PG8_LDA(At, 0, 1); PG8_STAGE(PG8_SB(0, 0), b2, voffB); PG8_STAGE(PG8_SB(0, 1), b2 + hstep, voffB); PG8_STAGE(PG8_SA(0, 0), a2, voffA);
            PG8_WAIT_V(8); PG8_WAIT_L(0); PG8_BAR; PG8_MMA(1, 0, At, B0); PG8_MMA(1, 1, At, B1); PG8_BAR; PG8_SCHED;
            PG8_LDB(B0, 1, 0); PG8_LDB(B1, 1, 1); PG8_SCHED; PG8_LDA(At, 1, 0); PG8_STAGE(PG8_SA(0, 1), a2 + hstepA, voffA);
            PG8_WAIT_V(8); PG8_WAIT_L(0); PG8_BAR; PG8_MMA(0, 0, At, B0); PG8_MMA(0, 1, At, B1); PG8_BAR; PG8_SCHED;
            PG8_LDA(At, 1, 1); PG8_STAGE(PG8_SB(1, 0), b3, voffB); PG8_STAGE(PG8_SB(1, 1), b3 + hstep, voffB); PG8_STAGE(PG8_SA(1, 0), a3, voffA);
            PG8_WAIT_V(8); PG8_WAIT_L(0); PG8_BAR; PG8_MMA(1, 0, At, B0); PG8_MMA(1, 1, At, B1); PG8_BAR; PG8_SCHED;
            } else {
            PG8_LDB(B0, 0, 0); PG8_SCHED; PG8_LDA(At, 0, 0); PG8_STAGE(PG8_SA(1, 1), a1 + hstepA, voffA);
            PG8_WAIT_L(8); PG8_BAR; PG8_WAIT_L(0); PG8_MMA(0, 0, At, B0); PG8_BAR; PG8_SCHED;
            PG8_LDB(B1, 0, 1); PG8_STAGE(PG8_SB(0, 0), b2, voffB);
            PG8_BAR; PG8_WAIT_L(0); PG8_MMA(0, 1, At, B1); PG8_BAR;
            PG8_LDA(At, 0, 1); PG8_STAGE(PG8_SA(0, 0), a2, voffA);
            PG8_BAR; PG8_WAIT_L(0); PG8_MMA(1, 0, At, B0); PG8_BAR; PG8_SCHED;
            PG8_STAGE(PG8_SB(0, 1), b2 + hstep, voffB);
            PG8_WAIT_V(6); PG8_BAR; PG8_MMA(1, 1, At, B1); PG8_BAR;
            PG8_LDB(B0, 1, 0); PG8_SCHED; PG8_LDA(At, 1, 0); PG8_STAGE(PG8_SA(0, 1), a2 + hstepA, voffA);
            PG8_WAIT_L(8); PG8_BAR; PG8_WAIT_L(0); PG8_MMA(0, 0, At, B0); PG8_BAR; PG8_SCHED;
            PG8_LDB(B1, 1, 1); PG8_STAGE(PG8_SB(1, 0), b3, voffB);
            PG8_BAR; PG8_WAIT_L(0); PG8_MMA(0, 1, At, B1); PG8_BAR;
            PG8_LDA(At, 1, 1); PG8_STAGE(PG8_SA(1, 0), a3, voffA);
            PG8_BAR; PG8_WAIT_L(0); PG8_MMA(1, 0, At, B0); PG8_BAR; PG8_SCHED;
            PG8_STAGE(PG8_SB(1, 1), b3 + hstep, voffB);
            PG8_WAIT_V(6); PG8_BAR; PG8_MMA(1, 1, At, B1); PG8_BAR;
            }
        }
        if constexpr (ALIGN_EPI) { if (wr == 0) PG8_BAR; }
        if constexpr (!Epi::AFTER_DRAIN) { E(acc, cur, wr, wc, fr, fq); S.done(cur); }
        if (!has_next) break;
#pragma unroll
        for (int a = 0; a < 2; ++a)
#pragma unroll
            for (int b = 0; b < 2; ++b)
#pragma unroll
                for (int m = 0; m < 4; ++m)
#pragma unroll
                    for (int n = 0; n < 2; ++n) acc[a][b][m][n] = (f32x4){0.f, 0.f, 0.f, 0.f};
        cur = nxt; cA = nA; cB = nB; ++ui;
        if constexpr (ALIGN_EPI) { if (wr == 1) PG8_BAR; }
    }
    PG8_WAIT_V(0);
    if constexpr (!ALIGN_EPI) { if (wr == 0) PG8_BAR; }
    PG8_BAR;
    if constexpr (Epi::AFTER_DRAIN) { E.fused(acc, cur, wr, wc, fr, fq, lds, wid, lane); S.done(cur); }
#undef PG8_SA
#undef PG8_SB
#undef PG8_STAGE
#undef PG8_LDA
#undef PG8_LDB
#undef PG8_MMA
#undef PG8_WAIT_V
#undef PG8_WAIT_L
#undef PG8_BAR
#undef PG8_SCHED
}

}

namespace pg8 {
struct EpiStore {
    static constexpr bool PERM = true, AFTER_DRAIN = false;
    bf16_t* O; int ldc; int nmain; float* dt; int nsilu; bf16_t* kvb; int hblocked;
    __device__ __forceinline__ void operator()(const f32x4 (&acc)[2][2][4][2], const Unit& u, int wr, int wc, int fr, int fq) const {
        const int row0 = u.pm * BM + wr * 64 + fr; const int colt = u.pn * BM;
        if (colt < nmain) {
            const int col0 = colt + wc * 32 + 8 * fq;
#pragma unroll
            for (int ai = 0; ai < 2; ++ai)
#pragma unroll
                for (int m = 0; m < 4; ++m) { const int grow = row0 + ai * HALF + m * 16; bf16_t* rowp = O + (size_t)grow * ldc + col0;
#pragma unroll
                    for (int bj = 0; bj < 2; ++bj) { f32x4 v0 = acc[ai][bj][m][0], v1 = acc[ai][bj][m][1];
                        if (colt < nsilu) {
#pragma unroll
                            for (int e = 0; e < 4; ++e) { v0[e] = silu_f(v0[e]); v1[e] = silu_f(v1[e]); } }
                        u32x4 w; w.x = cvtpk(v0[0], v0[1]); w.y = cvtpk(v0[2], v0[3]); w.z = cvtpk(v1[0], v1[1]); w.w = cvtpk(v1[2], v1[3]);
                        bf16_t* sp = rowp + bj * HALF;
                        if (kvb != nullptr && colt >= 1024) {
                            const int bb = grow >> 12, ss = grow & 4095;
                            if (colt < 2048) { const int cc = col0 + bj * HALF - 1024; sp = kvb + ((size_t)(((bb * 8 + (cc >> 7)) * 2 + ((cc >> 6) & 1)) * 4096 + ss)) * 64 + (cc & 63); }
                            else { const int cc = col0 + bj * HALF - 2048; sp = kvb + (size_t)4 * 8 * 2 * 4096 * 64 + ((size_t)((bb * 8 + (cc >> 7)) * 4096 + ss)) * 128 + (cc & 127); }
                        }
                        if (hblocked) sp = O + ((size_t)((colt + bj * HALF) >> 7) * MROWS + grow) * 128 + (unsigned)(col0 - colt);
                        *(u32x4*)sp = w; } }
        } else if (dt != nullptr && wc == 0) {
#pragma unroll
            for (int ai = 0; ai < 2; ++ai)
#pragma unroll
                for (int m = 0; m < 4; ++m) { float* p = dt + (size_t)(row0 + ai * HALF + m * 16) * 32 + 8 * fq;
                    *(f32x4*)p = acc[ai][0][m][0]; *(f32x4*)(p + 4) = acc[ai][0][m][1]; }
        }
    }
};
}

DI void transpose_item(const float* W, int K, int N, bf16_t* WT, LAS float* scr, int item, int lane, const float* gk, int gmask, float gscale, int nq, float qscale) {
    const int nblk = (N + 63) / 64, kb = item / nblk, nb = item % nblk, k0 = 64 * kb, n0 = 64 * nb;
    const bool colok = (n0 + lane) < N;
    const float* src = W + (size_t)k0 * N + n0 + (colok ? lane : 0);
    float v[64];
#pragma unroll
    for (int kk = 0; kk < 64; ++kk) v[kk] = __builtin_nontemporal_load(src + (size_t)kk * N);
#pragma unroll
    for (int kk = 0; kk < 64; ++kk) { const float g = gk ? gk[(k0 + kk) & gmask] * gscale : 1.0f; scr[kk * 65 + lane] = v[kk] * g; }
    LDS_WAIT(); asm volatile("" ::: "memory");
    const int c = lane & 7;
#pragma unroll
    for (int j = 0; j < 8; ++j) { const int n = (lane >> 3) + 8 * j; const LAS float* s = scr + (8 * c) * 65 + n; const float cs = (n0 + n < nq) ? qscale : 1.0f;
        u32x4 o; o.x = cvtpk(s[0 * 65] * cs, s[1 * 65] * cs); o.y = cvtpk(s[2 * 65] * cs, s[3 * 65] * cs); o.z = cvtpk(s[4 * 65] * cs, s[5 * 65] * cs); o.w = cvtpk(s[6 * 65] * cs, s[7 * 65] * cs);
        if (n0 + n < N) *(u32x4*)(WT + (size_t)(n0 + n) * K + k0 + 8 * c) = o; }
    LDS_WAIT(); asm volatile("" ::: "memory");
}

struct Ctx {
    float* out; unsigned char* ws;
    LAS unsigned char* lds;
    int tid, lane, wid, gw, ngw, bid;
};
constexpr int PTR_OFF = LDS_BYTES - 256;
DI const float* inp(const Ctx& c, int k) {
    const unsigned long long v = ((const LAS unsigned long long*)(c.lds + PTR_OFF))[k];
    const unsigned lo = __builtin_amdgcn_readfirstlane((unsigned)v), hi = __builtin_amdgcn_readfirstlane((unsigned)(v >> 32));
    return (const float*)(((unsigned long long)hi << 32) | lo);
}
DI float lambda_init(int i) { return (i == 1) ? 0.35550906759096926f : 0.5560582041556405f; }

DI void convert_phase(const Ctx& c, int kind, int i) {
    LAS float* scr = (LAS float*)(c.lds + c.wid * 16640);
    bf16_t* W1 = (bf16_t*)(c.ws + WS_W1); bf16_t* W2 = (bf16_t*)(c.ws + WS_W2);
    const int j = i >> 1;
    const float* WA; const float* WB; int KA = DM, NA, KB, NB_ = DM; const float* gA; const float* gB = nullptr; int maskB = 0; float gsB = 1.0f; int nq = 0; float qs = 1.0f;
    if (kind == 0) { WA = inp(c, 1) + (size_t)j * DM * NIN; NA = NIN; gA = inp(c, 16) + i * DM; WB = inp(c, 8) + (size_t)j * DIN * DM; KB = DIN; gB = inp(c, 7) + j * DIN; maskB = DIN - 1; }
    else if (kind == 1) { WA = inp(c, 9) + (size_t)j * DM * NQKV; NA = NQKV; gA = inp(c, 16) + i * DM; nq = DM; qs = 0.125f * LOG2E;
                          WB = inp(c, 15) + (size_t)j * DM * DM; KB = DM; gB = inp(c, 14) + j * 128; maskB = 127; gsB = 1.0f - lambda_init(i); }
    else { WA = inp(c, 20) + (size_t)i * DM * NUP; NA = NUP; gA = inp(c, 18) + i * DM; WB = inp(c, 23) + (size_t)i * DFF * DM; KB = DFF; }
    const int nA = (KA / 64) * ((NA + 63) / 64), nB = (KB / 64) * (NB_ / 64);
    for (int it = c.gw; it < nA + nB; it += c.ngw) {
        if (it < nA) transpose_item(WA, KA, NA, W1, scr, it, c.lane, gA, DM - 1, 1.0f, nq, qs);
        else transpose_item(WB, KB, NB_, W2, scr, it - nA, c.lane, gB, maskB, gsB, 0, 1.0f);
    }
    if (kind == 0) {
        u32x4* z = (u32x4*)(W1 + (size_t)NIN * DM); const int n16 = (NINP - NIN) * DM / 8;
        for (int t = c.gw * 64 + c.lane; t < n16; t += c.ngw * 64) z[t] = (u32x4){0u, 0u, 0u, 0u};
    }
}

DI void rowwise_phase(const Ctx& c, const float* xin, const bf16_t* Mb, const float* gpost, const float* xsrc, float* xres, bf16_t* XN, bool last) {
    constexpr int RB = 4;
    for (int row0 = c.gw * RB; row0 < MROWS; row0 += c.ngw * RB) {
        f32x4 v[RB][4];
        if (xin) {
#pragma unroll
            for (int rr = 0; rr < RB; ++rr)
#pragma unroll
                for (int j = 0; j < 4; ++j) v[rr][j] = __builtin_nontemporal_load((const f32x4*)(xin + (size_t)(row0 + rr) * DM + 4 * c.lane + 256 * j));
        } else {
            u32x2 mw[RB][4]; f32x4 g[4];
#pragma unroll
            for (int rr = 0; rr < RB; ++rr)
#pragma unroll
                for (int j = 0; j < 4; ++j) { mw[rr][j] = __builtin_nontemporal_load((const u32x2*)(Mb + (size_t)(row0 + rr) * DM + 4 * c.lane + 256 * j)); v[rr][j] = __builtin_nontemporal_load((const f32x4*)(xsrc + (size_t)(row0 + rr) * DM + 4 * c.lane + 256 * j)); }
#pragma unroll
            for (int j = 0; j < 4; ++j) g[j] = *(const f32x4*)(gpost + 4 * c.lane + 256 * j);
#pragma unroll
            for (int rr = 0; rr < RB; ++rr) {
                f32x4 mv[4]; float ss = 0.f;
#pragma unroll
                for (int j = 0; j < 4; ++j) { const u32x2 w = mw[rr][j]; mv[j] = (f32x4){bflo(w.x), bfhi(w.x), bflo(w.y), bfhi(w.y)}; ss += (mv[j].x * mv[j].x + mv[j].y * mv[j].y) + (mv[j].z * mv[j].z + mv[j].w * mv[j].w); }
                const float rm = rsqrtf(wave_sum(ss) * (1.0f / DM) + EPS);
#pragma unroll
                for (int j = 0; j < 4; ++j) v[rr][j] = v[rr][j] + mv[j] * rm * g[j];
            }
        }
#pragma unroll
        for (int rr = 0; rr < RB; ++rr) {
            if (xres) {
#pragma unroll
                for (int j = 0; j < 4; ++j) __builtin_nontemporal_store(v[rr][j], (f32x4*)(xres + (size_t)(row0 + rr) * DM + 4 * c.lane + 256 * j));
            }
            if (!last) {
                float s2 = 0.f;
#pragma unroll
                for (int j = 0; j < 4; ++j) s2 += (v[rr][j].x * v[rr][j].x + v[rr][j].y * v[rr][j].y) + (v[rr][j].z * v[rr][j].z + v[rr][j].w * v[rr][j].w);
                const float rs = rsqrtf(wave_sum(s2) * (1.0f / DM) + EPS);
#pragma unroll
                for (int j = 0; j < 4; ++j) { u32x2 o; o.x = cvtpk(v[rr][j].x * rs, v[rr][j].y * rs); o.y = cvtpk(v[rr][j].z * rs, v[rr][j].w * rs); *(u32x2*)(XN + (size_t)(row0 + rr) * DM + 4 * c.lane + 256 * j) = o; }
            }
        }
    }
}

DI void ffn_gate_phase(const Ctx& c, int i) {
    const bf16_t* H = (const bf16_t*)(c.ws + WS_BIG); bf16_t* ACT = (bf16_t*)(c.ws + WS_ACT);
    const float* cw = inp(c, 21) + (size_t)i * 3 * NUP; const float* cb = inp(c, 22) + (size_t)i * NUP;
    constexpr int NCH = DFF / 8, RUN = 8, NRUN = MROWS / RUN;
    const int gt = c.bid * 512 + c.tid, nrg = (gridDim.x * 512) / NCH;
    if (gt >= nrg * NCH) return;
    const int ch = gt % NCH, rg = gt / NCH, col = ch * 8;
    float wg[3][8], wu[3][8], bg[8], bu[8];
#pragma unroll
    for (int k = 0; k < 3; ++k) {
        const f32x4 a0 = *(const f32x4*)(cw + k * NUP + col), a1 = *(const f32x4*)(cw + k * NUP + col + 4);
        const f32x4 b0 = *(const f32x4*)(cw + k * NUP + DFF + col), b1 = *(const f32x4*)(cw + k * NUP + DFF + col + 4);
#pragma unroll
        for (int e = 0; e < 4; ++e) { wg[k][e] = a0[e]; wg[k][4 + e] = a1[e]; wu[k][e] = b0[e]; wu[k][4 + e] = b1[e]; }
    }
    { const f32x4 a0 = *(const f32x4*)(cb + col), a1 = *(const f32x4*)(cb + col + 4), b0 = *(const f32x4*)(cb + DFF + col), b1 = *(const f32x4*)(cb + DFF + col + 4);
#pragma unroll
      for (int e = 0; e < 4; ++e) { bg[e] = a0[e]; bg[4 + e] = a1[e]; bu[e] = b0[e]; bu[4 + e] = b1[e]; } }
#pragma unroll 1
    for (int run = rg; run < NRUN; run += nrg) {
        const int row0 = run * RUN; const bool first = (row0 & (SEQ - 1)) == 0;
        u32x4 ga[RUN + 2], ua[RUN + 2];
        const bf16_t* hg = H + ((size_t)(col >> 7) * MROWS + row0) * 128 + (col & 127); const bf16_t* hu = hg + (size_t)22 * MROWS * 128;
#pragma unroll
        for (int r = 0; r < RUN + 2; ++r) {
            if (r < 2 && first) { ga[r] = (u32x4){0u, 0u, 0u, 0u}; ua[r] = (u32x4){0u, 0u, 0u, 0u}; }
            else { ga[r] = __builtin_nontemporal_load((const u32x4*)(hg + (r - 2) * 128)); ua[r] = __builtin_nontemporal_load((const u32x4*)(hu + (r - 2) * 128)); }
        }
        float g2[8], g1[8], u2[8], u1[8];
#pragma unroll
        for (int e = 0; e < 4; ++e) { g2[2 * e] = bflo(ga[0][e]); g2[2 * e + 1] = bfhi(ga[0][e]); g1[2 * e] = bflo(ga[1][e]); g1[2 * e + 1] = bfhi(ga[1][e]);
                                      u2[2 * e] = bflo(ua[0][e]); u2[2 * e + 1] = bfhi(ua[0][e]); u1[2 * e] = bflo(ua[1][e]); u1[2 * e + 1] = bfhi(ua[1][e]); }
#pragma unroll
        for (int r = 0; r < RUN; ++r) {
            float g0[8], u0[8], o[8];
#pragma unroll
            for (int e = 0; e < 4; ++e) { g0[2 * e] = bflo(ga[r + 2][e]); g0[2 * e + 1] = bfhi(ga[r + 2][e]); u0[2 * e] = bflo(ua[r + 2][e]); u0[2 * e + 1] = bfhi(ua[r + 2][e]); }
#pragma unroll
            for (int e = 0; e < 8; ++e) { const float yg = bg[e] + wg[0][e] * g2[e] + wg[1][e] * g1[e] + wg[2][e] * g0[e]; const float yu = bu[e] + wu[0][e] * u2[e] + wu[1][e] * u1[e] + wu[2][e] * u0[e];
                o[e] = silu_f(yg) * yu; g2[e] = g1[e]; g1[e] = g0[e]; u2[e] = u1[e]; u1[e] = u0[e]; }
            u32x4 w; w.x = cvtpk(o[0], o[1]); w.y = cvtpk(o[2], o[3]); w.z = cvtpk(o[4], o[5]); w.w = cvtpk(o[6], o[7]);
            *(u32x4*)(ACT + (size_t)(row0 + r) * DFF + col) = w;
        }
    }
}

DI void ssm_conv8(const bf16_t* proj, int row, int t, int ch, const float (&w)[4][8], const float (&b)[8], float (&o)[8]) {
#pragma unroll
    for (int e = 0; e < 8; ++e) o[e] = b[e];
#pragma unroll
    for (int k = 0; k < 4; ++k) {
        if (t - 3 + k >= 0) {
            const u32x4 v = *(const u32x4*)(proj + (size_t)(row - 3 + k) * NPROJ + DIN + ch);
#pragma unroll
            for (int e = 0; e < 4; ++e) { o[2 * e] += w[k][2 * e] * bflo(v[e]); o[2 * e + 1] += w[k][2 * e + 1] * bfhi(v[e]); }
        }
    }
#pragma unroll
    for (int e = 0; e < 8; ++e) o[e] = silu_f(o[e]);
}
DI void ssm_conv_run4(const bf16_t* proj, int row, int t, int ch, const float (&w)[4][8], const float (&b)[8], float (&o)[4][8]) {
    u32x4 raw[7];
#pragma unroll
    for (int k = 0; k < 7; ++k) { if (k < 3 && t == 0) raw[k] = (u32x4){0u, 0u, 0u, 0u}; else raw[k] = *(const u32x4*)(proj + (size_t)(row - 3 + k) * NPROJ + DIN + ch); }
    float x[7][8];
#pragma unroll
    for (int k = 0; k < 7; ++k)
#pragma unroll
        for (int e = 0; e < 4; ++e) { x[k][2 * e] = bflo(raw[k][e]); x[k][2 * e + 1] = bfhi(raw[k][e]); }
#pragma unroll
    for (int r = 0; r < 4; ++r)
#pragma unroll
        for (int e = 0; e < 8; ++e) o[r][e] = silu_f(b[e] + w[0][e] * x[r][e] + w[1][e] * x[r + 1][e] + w[2][e] * x[r + 2][e] + w[3][e] * x[r + 3][e]);
}
DI void ssm_conv_w8(const float* cw, const float* cb, int ch, float (&w)[4][8], float (&b)[8]) {
#pragma unroll
    for (int k = 0; k < 4; ++k) { const f32x4 a0 = *(const f32x4*)(cw + k * XBC + ch), a1 = *(const f32x4*)(cw + k * XBC + ch + 4);
#pragma unroll
        for (int e = 0; e < 4; ++e) { w[k][e] = a0[e]; w[k][4 + e] = a1[e]; } }
    const f32x4 a0 = *(const f32x4*)(cb + ch), a1 = *(const f32x4*)(cb + ch + 4);
#pragma unroll
    for (int e = 0; e < 4; ++e) { b[e] = a0[e]; b[4 + e] = a1[e]; }
}
DI void ssd_dt_prep(const Ctx& c, int j, int row0, int g, LAS float* dtv, LAS float* acs, LAS float* tot) {
    const float* DT = (const float*)(c.ws + WS_DT);
    const int h = c.tid >> 7, l = c.tid & 127, head = g * 4 + h;
    const float dt = DT[(size_t)(row0 + l) * 32 + head];
    const float A = -__expf(inp(c, 5)[j * 32 + head]);
    float s = dt * A;
#pragma unroll
    for (int o = 1; o < 64; o <<= 1) { const float n = __shfl_up(s, o); if (c.lane >= o) s += n; }
    if (c.lane == 63) tot[c.wid] = s;
    dtv[h * 128 + l] = dt;
    __syncthreads();
    if (c.wid & 1) s += tot[c.wid - 1];
    acs[h * 128 + l] = s;
    __syncthreads();
}

DI int tsw(int row, int col) { return row * 136 + ((((col >> 3) ^ (row >> 3)) & 7) | ((col >> 3) & 8)) * 8 + (col & 7); }

DI void dt_proj_phase(const Ctx& c, const bf16_t* XN, const bf16_t* W1, float* DT, const float* dtb) {
    LAS float* part = (LAS float*)c.lds;
    const int r = c.lane & 31, hh = c.lane >> 5, rt = c.wid & 1, kq = c.wid >> 1;
    for (int blk = c.bid; blk < MROWS / 64; blk += gridDim.x) {
        const bf16_t* ap = XN + (size_t)(blk * 64 + rt * 32 + r) * DM + kq * 256 + 8 * hh;
        const bf16_t* bp = W1 + (size_t)(NPROJ + r) * DM + kq * 256 + 8 * hh;
        bf16x8 av[16], bv[16];
#pragma unroll
        for (int ks = 0; ks < 16; ++ks) { av[ks] = *(const bf16x8*)(ap + 16 * ks); bv[ks] = *(const bf16x8*)(bp + 16 * ks); }
        f32x16 acc;
#pragma unroll
        for (int e = 0; e < 16; ++e) acc[e] = 0.f;
#pragma unroll
        for (int ks = 0; ks < 16; ++ks) acc = MFMA32(av[ks], bv[ks], acc);
#pragma unroll
        for (int e = 0; e < 16; ++e) part[(c.wid * 16 + e) * 64 + c.lane] = acc[e];
        __syncthreads();
        if (kq == 0) {
#pragma unroll
            for (int e = 0; e < 16; ++e) { const float v = part[((rt) * 16 + e) * 64 + c.lane] + part[((rt + 2) * 16 + e) * 64 + c.lane] + part[((rt + 4) * 16 + e) * 64 + c.lane] + part[((rt + 6) * 16 + e) * 64 + c.lane];
                const float raw = v + dtb[r];
                DT[(size_t)(blk * 64 + rt * 32 + crow(e, hh)) * 32 + r] = raw > 20.0f ? raw : log1pf(__expf(raw)); }
        }
        __syncthreads();
    }
}

DI void ssd_states_phase(const Ctx& c, int j) {
    const bf16_t* proj = (const bf16_t*)(c.ws + WS_BIG); bf16_t* ST = (bf16_t*)(c.ws + WS_ST); float* CD = (float*)(c.ws + WS_CD);
    const float* cw = inp(c, 2) + (size_t)j * 4 * XBC; const float* cb = inp(c, 3) + (size_t)j * XBC;
    LAS bf16_t* XT = (LAS bf16_t*)c.lds;
    LAS bf16_t* BT = XT + 256 * 136;
    LAS float* dtv = (LAS float*)(BT + 128 * 136);
    LAS float* acs = dtv + 512; LAS float* wgt = acs + 512; LAS float* tot = wgt + 512;
    const int r = c.lane & 31, hh = c.lane >> 5;
    for (int item = c.bid; item < 1024; item += gridDim.x) {
        const int b = item >> 8, ci = (item >> 3) & 31, g = item & 7, row0 = b * SEQ + ci * 128, t0 = ci * 128;
        ssd_dt_prep(c, j, row0, g, dtv, acs, tot);
        { const int h = c.tid >> 7, l = c.tid & 127; const float last = acs[h * 128 + 127], s = acs[h * 128 + l];
          wgt[h * 128 + l] = dtv[h * 128 + l] * __expf(last - s);
          if (l == 127) CD[(b * 32 + ci) * 32 + g * 4 + h] = __expf(s); }
        __syncthreads();
        {
            const int chunk = c.tid & 31, ch = g * 256 + chunk * 8, h = chunk >> 3; float w[4][8], bb[8]; ssm_conv_w8(cw, cb, ch, w, bb);
#pragma unroll
            for (int it = 0; it < 2; ++it) { const int l = 4 * ((c.tid >> 5) + 16 * it); float o[4][8]; ssm_conv_run4(proj, row0 + l, t0 + l, ch, w, bb, o);
                const f32x4 sc = *(const LAS f32x4*)(wgt + h * 128 + l);
#pragma unroll
                for (int e = 0; e < 8; ++e) { u32x2 v; v.x = cvtpk(o[0][e] * sc[0], o[1][e] * sc[1]); v.y = cvtpk(o[2][e] * sc[2], o[3][e] * sc[3]); *(LAS u32x2*)(XT + tsw(chunk * 8 + e, l)) = v; } }
        }
        {
            const int chunk = c.tid & 15, ch = DIN + g * 128 + chunk * 8, l = 4 * (c.tid >> 4); float w[4][8], bb[8]; ssm_conv_w8(cw, cb, ch, w, bb);
            float o[4][8]; ssm_conv_run4(proj, row0 + l, t0 + l, ch, w, bb, o);
#pragma unroll
            for (int e = 0; e < 8; ++e) { u32x2 v; v.x = cvtpk(o[0][e], o[1][e]); v.y = cvtpk(o[2][e], o[3][e]); *(LAS u32x2*)(BT + tsw(chunk * 8 + e, l)) = v; }
        }
        __syncthreads();
        {
            const int h = c.wid >> 1, pt = c.wid & 1; f32x16 acc[4];
#pragma unroll
            for (int nt = 0; nt < 4; ++nt)
#pragma unroll
                for (int e = 0; e < 16; ++e) acc[nt][e] = 0.f;
#pragma unroll
            for (int ks = 0; ks < 8; ++ks) { const bf16x8 bop = *(const LAS bf16x8*)(XT + tsw(h * 64 + pt * 32 + r, 16 * ks + 8 * hh));
#pragma unroll
                for (int nt = 0; nt < 4; ++nt) { const bf16x8 a = *(const LAS bf16x8*)(BT + tsw(nt * 32 + r, 16 * ks + 8 * hh)); acc[nt] = MFMA32(a, bop, acc[nt]); } }
            bf16_t* dst = ST + (size_t)((b * 32 + ci) * 32 + g * 4 + h) * 8192;
#pragma unroll
            for (int nt = 0; nt < 4; ++nt)
#pragma unroll
                for (int q = 0; q < 4; ++q) { u32x2 o; o.x = cvtpk(acc[nt][4 * q], acc[nt][4 * q + 1]); o.y = cvtpk(acc[nt][4 * q + 2], acc[nt][4 * q + 3]); *(u32x2*)(dst + (((pt * 8 + nt * 2 + (q >> 1)) * 64 + (q & 1) * 32 + r) * 8 + 4 * hh)) = o; }
        }
        __syncthreads();
    }
}

DI void ssd_scan_phase(const Ctx& c) {
    bf16_t* ST = (bf16_t*)(c.ws + WS_ST); const float* CD = (const float*)(c.ws + WS_CD);
    for (int idx = c.bid * 512 + c.tid; idx < 4 * 32 * 1024; idx += gridDim.x * 512) {
        const int e8 = idx & 1023, head = (idx >> 10) & 31, b = idx >> 15; float carry[8];
#pragma unroll
        for (int e = 0; e < 8; ++e) carry[e] = 0.f;
#pragma unroll 16
        for (int ci = 0; ci < 32; ++ci) { u32x4* p = (u32x4*)(ST + ((size_t)((b * 32 + ci) * 32 + head) * 8192 + e8 * 8)); const u32x4 s = *p; const float dec = CD[(b * 32 + ci) * 32 + head];
            u32x4 o; o.x = cvtpk(carry[0], carry[1]); o.y = cvtpk(carry[2], carry[3]); o.z = cvtpk(carry[4], carry[5]); o.w = cvtpk(carry[6], carry[7]); *p = o;
#pragma unroll
            for (int e = 0; e < 4; ++e) { carry[2 * e] = carry[2 * e] * dec + bflo(s[e]); carry[2 * e + 1] = carry[2 * e + 1] * dec + bfhi(s[e]); } }
    }
}

DI void ssd_out_phase(const Ctx& c, int j) {
    const bf16_t* proj = (const bf16_t*)(c.ws + WS_BIG); const bf16_t* ST = (const bf16_t*)(c.ws + WS_ST); bf16_t* Y = (bf16_t*)(c.ws + WS_Y);
    const float* cw = inp(c, 2) + (size_t)j * 4 * XBC; const float* cb = inp(c, 3) + (size_t)j * XBC;
    LAS bf16_t* Cn = (LAS bf16_t*)c.lds;
    LAS bf16_t* Bn = Cn + 128 * 136;
    LAS bf16_t* XT = Bn + 128 * 136;
    LAS float* dtv = (LAS float*)(XT + 256 * 136);
    LAS float* acs = dtv + 512; LAS float* tot = acs + 512; LAS float* red = tot + 8;
    const int r = c.lane & 31, hh = c.lane >> 5, h = c.wid >> 1, ph = c.wid & 1;
    for (int item = c.bid; item < 1024; item += gridDim.x) {
        const int b = item >> 8, ci = (item >> 3) & 31, g = item & 7, row0 = b * SEQ + ci * 128, t0 = ci * 128, head = g * 4 + h;
        bf16x8 pvf[8];
        { const bf16_t* src = ST + (size_t)((b * 32 + ci) * 32 + head) * 8192 + ((ph * 8) * 64 + hh * 32 + r) * 8;
#pragma unroll
          for (int ks = 0; ks < 8; ++ks) pvf[ks] = *(const bf16x8*)(src + ks * 512); }
        ssd_dt_prep(c, j, row0, g, dtv, acs, tot);
        {
            const int chunk = c.tid & 15, l = 4 * (c.tid >> 4);
            { const int ch = DIN + g * 128 + chunk * 8; float w[4][8], bb[8]; ssm_conv_w8(cw, cb, ch, w, bb); float o[4][8]; ssm_conv_run4(proj, row0 + l, t0 + l, ch, w, bb, o);
#pragma unroll
              for (int rr = 0; rr < 4; ++rr) { u32x4 v; v.x = cvtpk(o[rr][0], o[rr][1]); v.y = cvtpk(o[rr][2], o[rr][3]); v.z = cvtpk(o[rr][4], o[rr][5]); v.w = cvtpk(o[rr][6], o[rr][7]); *(LAS u32x4*)(Bn + (l + rr) * 136 + chunk * 8) = v; } }
            { const int ch = DIN + 1024 + g * 128 + chunk * 8; float w[4][8], bb[8]; ssm_conv_w8(cw, cb, ch, w, bb); float o[4][8]; ssm_conv_run4(proj, row0 + l, t0 + l, ch, w, bb, o);
#pragma unroll
              for (int rr = 0; rr < 4; ++rr) { u32x4 v; v.x = cvtpk(o[rr][0], o[rr][1]); v.y = cvtpk(o[rr][2], o[rr][3]); v.z = cvtpk(o[rr][4], o[rr][5]); v.w = cvtpk(o[rr][6], o[rr][7]); *(LAS u32x4*)(Cn + (l + rr) * 136 + chunk * 8) = v; } }
        }
        {
            const int chunk = c.tid & 31, ch = g * 256 + chunk * 8; float w[4][8], bb[8]; ssm_conv_w8(cw, cb, ch, w, bb);
#pragma unroll
            for (int it = 0; it < 2; ++it) { const int l = 4 * ((c.tid >> 5) + 16 * it); float o[4][8]; ssm_conv_run4(proj, row0 + l, t0 + l, ch, w, bb, o);
#pragma unroll
                for (int e = 0; e < 8; ++e) { u32x2 v; v.x = cvtpk(o[0][e], o[1][e]); v.y = cvtpk(o[2][e], o[3][e]); *(LAS u32x2*)(XT + tsw(chunk * 8 + e, l)) = v; } }
        }
        __syncthreads();
        const float Dh = inp(c, 6)[j * 32 + head];
#pragma unroll 1
        for (int lb = 0; lb < 4; ++lb) {
            const int l = lb * 32 + r; f32x16 accl;
            u32x2 zz[4];
#pragma unroll
            for (int q = 0; q < 4; ++q) zz[q] = *(const u32x2*)(proj + (size_t)(row0 + l) * NPROJ + g * 256 + h * 64 + ph * 32 + 8 * q + 4 * hh);
#pragma unroll
            for (int e = 0; e < 16; ++e) accl[e] = 0.f;
#pragma unroll
            for (int ks = 0; ks < 8; ++ks) { const bf16x8 bop = *(const LAS bf16x8*)(Cn + l * 136 + 16 * ks + 8 * hh); accl = MFMA32(pvf[ks], bop, accl); }
            const float al = acs[h * 128 + l]; const float eal = __expf(al);
#pragma unroll
            for (int e = 0; e < 16; ++e) accl[e] *= eal;
#pragma unroll 1
            for (int sb = 0; sb <= lb; ++sb) {
                f32x16 cbt;
#pragma unroll
                for (int e = 0; e < 16; ++e) cbt[e] = 0.f;
#pragma unroll
                for (int ks = 0; ks < 8; ++ks) { const bf16x8 a = *(const LAS bf16x8*)(Bn + (sb * 32 + r) * 136 + 16 * ks + 8 * hh); const bf16x8 bop = *(const LAS bf16x8*)(Cn + l * 136 + 16 * ks + 8 * hh);
                    cbt = MFMA32(a, bop, cbt); }
                f32x4 av[4], dv[4];
#pragma unroll
                for (int q = 0; q < 4; ++q) { av[q] = *(const LAS f32x4*)(acs + h * 128 + sb * 32 + 8 * q + 4 * hh); dv[q] = *(const LAS f32x4*)(dtv + h * 128 + sb * 32 + 8 * q + 4 * hh); }
#pragma unroll
                for (int ss = 0; ss < 2; ++ss) {
                    float v[8];
#pragma unroll
                    for (int jj = 0; jj < 8; ++jj) { const int i = 8 * ss + jj, s = sb * 32 + crow(i, hh); const float e = (sb < lb || s <= l) ? __expf(al - av[i >> 2][i & 3]) * dv[i >> 2][i & 3] : 0.f;
                        v[jj] = cbt[i] * e + ((s == l) ? Dh : 0.f); }
                    u32x4 pk; pk.x = cvtpk(v[0], v[1]); pk.y = cvtpk(v[2], v[3]); pk.z = cvtpk(v[4], v[5]); pk.w = cvtpk(v[6], v[7]);
                    const bf16x8 bop = __builtin_bit_cast(bf16x8, pk);
                    const int xrow = h * 64 + ph * 32 + r, xcol = sb * 32 + 16 * ss + 4 * hh;
                    const s16x4 lo = *(const LAS s16x4*)(XT + tsw(xrow, xcol)), hi = *(const LAS s16x4*)(XT + tsw(xrow, xcol + 8));
                    const bf16x8 a = __builtin_shufflevector(lo, hi, 0, 1, 2, 3, 4, 5, 6, 7);
                    accl = MFMA32(a, bop, accl);
                }
            }
            float sq = 0.f;
#pragma unroll
            for (int q = 0; q < 4; ++q) {
                const float zf[4] = {bflo(zz[q].x), bfhi(zz[q].x), bflo(zz[q].y), bfhi(zz[q].y)};
#pragma unroll
                for (int e = 0; e < 4; ++e) { const float yv = accl[4 * q + e] * zf[e]; accl[4 * q + e] = yv; sq += yv * yv; }
            }
            sq += __shfl_xor(sq, 32);
            LAS float* redb = red + (lb & 1) * 256;
            if (hh == 0) redb[c.wid * 32 + r] = sq;
            __syncthreads();
            float tsum = 0.f;
#pragma unroll
            for (int w8 = 0; w8 < 8; ++w8) tsum += redb[w8 * 32 + r];
            const float rstd = rsqrtf(tsum * (1.0f / 256.0f) + EPS);
#pragma unroll
            for (int q = 0; q < 4; ++q) { u32x2 o; o.x = cvtpk(accl[4 * q] * rstd, accl[4 * q + 1] * rstd); o.y = cvtpk(accl[4 * q + 2] * rstd, accl[4 * q + 3] * rstd);
                *(u32x2*)(Y + (size_t)(row0 + l) * DIN + g * 256 + h * 64 + ph * 32 + 8 * q + 4 * hh) = o; }
        }
        __syncthreads();
    }
}

DI void attn_load_tile(const bf16_t* KVB, int b, int h, int t, int kt, int tid, u32x4& kreg, u32x4 (&vreg)[2]) {
    const bf16_t* kb = KVB + ((size_t)(((b * 8 + h) * 2 + t) * 4096 + kt * 64)) * 64;
    const bf16_t* vb = KVB + (size_t)4 * 8 * 2 * 4096 * 64 + ((size_t)((b * 8 + h) * 4096 + kt * 64)) * 128;
    kreg = *(const u32x4*)(kb + (unsigned)tid * 8u);
#pragma unroll
    for (int kk = 0; kk < 2; ++kk) vreg[kk] = *(const u32x4*)(vb + (unsigned)tid * 8u + kk * 4096);
}
DI void attn_store_tile(LAS bf16_t* Kn, LAS bf16_t* Vn, int tid, const u32x4& kreg, const u32x4 (&vreg)[2]) {
    *(LAS u32x4*)(Kn + (tid >> 3) * 72 + 8 * (tid & 7)) = kreg;
#pragma unroll
    for (int kk = 0; kk < 2; ++kk) *(LAS u32x4*)(Vn + ((tid >> 4) + 32 * kk) * 160 + 8 * (tid & 15)) = vreg[kk];
}
typedef short v4i16_t __attribute__((ext_vector_type(4)));
DI s16x4 vtr(const LAS bf16_t* p) { return __builtin_bit_cast(s16x4, __builtin_amdgcn_ds_read_tr16_b64_v4i16((LAS v4i16_t*)p)); }
DI void attn_tile(const LAS bf16_t* Kn, const LAS bf16_t* Vt, const bf16x8 (&Qf)[4], int tidv, int kv0, int q0w, int qpos, float c2, float& m, float& lsum, f32x16 (&O)[4]) {
    if (kv0 > q0w + 31) return;
    const int r = tidv & 31, hh = (tidv >> 5) & 1;
    const LAS bf16_t* vbase = Vt + (4 * hh + ((tidv & 15) >> 2)) * 160 + 16 * ((tidv >> 4) & 1) + 4 * (tidv & 3);
    f32x16 st[2];
#pragma unroll
    for (int kb = 0; kb < 2; ++kb)
#pragma unroll
        for (int e = 0; e < 16; ++e) st[kb][e] = 0.f;
#pragma unroll
    for (int ks = 0; ks < 4; ++ks) {
        const bf16x8 qf = Qf[ks];
#pragma unroll
        for (int kb = 0; kb < 2; ++kb) { const bf16x8 a = *(const LAS bf16x8*)(Kn + (kb * 32 + r) * 72 + 16 * ks + 8 * hh); st[kb] = MFMA32(a, qf, st[kb]); }
    }
    const float fb = (float)(kv0 + 4 * hh - qpos);
#pragma unroll
    for (int kb = 0; kb < 2; ++kb)
#pragma unroll
        for (int e = 0; e < 16; ++e) st[kb][e] = fmaf(c2, fb + (float)(kb * 32 + 8 * (e >> 2) + (e & 3)), st[kb][e]);
    if (kv0 + 63 > q0w) {
#pragma unroll
        for (int kb = 0; kb < 2; ++kb)
#pragma unroll
            for (int e = 0; e < 16; ++e) { const int kpos = kv0 + kb * 32 + crow(e, hh); if (kpos > qpos) st[kb][e] = -INFINITY; }
    }
    float mx = __builtin_fmaxf(st[0][0], st[1][0]);
#pragma unroll
    for (int e = 1; e < 16; ++e) mx = __builtin_fmaxf(__builtin_fmaxf(mx, st[0][e]), st[1][e]);
    { const auto sw = __builtin_amdgcn_permlane32_swap(__float_as_uint(mx), __float_as_uint(mx), false, false); mx = fmaxf(__uint_as_float(sw[0]), __uint_as_float(sw[1])); }
    const float mn = fmaxf(m, mx), alpha = __builtin_amdgcn_exp2f(m - mn); m = mn;
    f32x2_t ps2 = {0.f, 0.f};
#pragma unroll
    for (int kb = 0; kb < 2; ++kb)
#pragma unroll
        for (int e = 0; e < 16; e += 2) { const float p0 = __builtin_amdgcn_exp2f(st[kb][e] - mn), p1 = __builtin_amdgcn_exp2f(st[kb][e + 1] - mn); st[kb][e] = p0; st[kb][e + 1] = p1; ps2 += (f32x2_t){p0, p1}; }
    lsum = lsum * alpha + (ps2.x + ps2.y);
    if (__builtin_amdgcn_ballot_w64(alpha != 1.0f) != 0ull) {
#pragma unroll
        for (int et = 0; et < 4; ++et)
#pragma unroll
            for (int e = 0; e < 16; ++e) O[et][e] *= alpha;
    }
#pragma unroll
    for (int kb = 0; kb < 2; ++kb)
#pragma unroll
        for (int ss = 0; ss < 2; ++ss) {
            u32x4 pk; pk.x = cvtpk(st[kb][8 * ss], st[kb][8 * ss + 1]); pk.y = cvtpk(st[kb][8 * ss + 2], st[kb][8 * ss + 3]); pk.z = cvtpk(st[kb][8 * ss + 4], st[kb][8 * ss + 5]); pk.w = cvtpk(st[kb][8 * ss + 6], st[kb][8 * ss + 7]);
            const bf16x8 bop = __builtin_bit_cast(bf16x8, pk);
#pragma unroll
            for (int et = 0; et < 4; ++et) { const LAS bf16_t* vp = vbase + (kb * 32 + 16 * ss) * 160 + et * 32; const s16x4 lo = vtr(vp), hi = vtr(vp + 8 * 160);
                const bf16x8 a = __builtin_shufflevector(lo, hi, 0, 1, 2, 3, 4, 5, 6, 7); O[et] = MFMA32(a, bop, O[et]); }
        }
}
DI void attn_phase(const Ctx& c, int i) {
    const int j = i >> 1;
    const bf16_t* QKV = (const bf16_t*)(c.ws + WS_BIG); const bf16_t* KVB = (const bf16_t*)(c.ws + WS_KVB); bf16_t* AO = (bf16_t*)(c.ws + WS_Y);
    LAS bf16_t* KV0 = (LAS bf16_t*)c.lds;
#define KNB(bb) (KV0 + (bb) * 14848)
#define VTB(bb) (KV0 + (bb) * 14848 + 64 * 72)
    const int r = c.lane & 31, hh = c.lane >> 5;
    for (int up = c.bid; up < 256; up += gridDim.x) {
        const int bh = up >> 3, qsel = up & 7, b = bh >> 3, h = bh & 7;
        const float c2 = exp2f(-(float)(h + 1)) * LOG2E;
#pragma unroll 1
        for (int which = 0; which < 2; ++which) {
            const int qb = which ? qsel : 15 - qsel, q0w = qb * 256 + c.wid * 32, qpos = q0w + r, ntile = 4 * (qb + 1);
            const bf16_t* qbase = QKV + (size_t)(b * SEQ + q0w) * NQKV + h * 128;
            bf16_t* obase = AO + (size_t)(b * SEQ + q0w) * DM + h * 128;
            LAS unsigned* O1S = (LAS unsigned*)(KV0 + 2 * 14848) + c.wid * 32 * 64;

#pragma unroll 1
            for (int t = 0; t < 2; ++t) {
                bf16x8 Qf[4];
                { int tq = c.tid; asm volatile("" : "+v"(tq)); const unsigned qoff = (unsigned)((tq & 31) * NQKV + 8 * ((tq >> 5) & 1));
#pragma unroll
                  for (int ks = 0; ks < 4; ++ks) Qf[ks] = *(const bf16x8*)(qbase + t * 64 + 16 * ks + qoff); }
                f32x16 O[4];
#pragma unroll
                for (int et = 0; et < 4; ++et)
#pragma unroll
                    for (int e = 0; e < 16; ++e) O[et][e] = 0.f;
                float m = -1e30f, lsum = 0.f;
                u32x4 kregA, vregA[2], kregB, vregB[2];
                attn_load_tile(KVB, b, h, t, 0, c.tid, kregA, vregA);
                attn_load_tile(KVB, b, h, t, 1, c.tid, kregB, vregB);
                attn_store_tile(KNB(0), VTB(0), c.tid, kregA, vregA);
                __syncthreads();
#pragma unroll 1
                for (int kt = 0; kt < ntile; kt += 2) {
                    int tidv = c.tid; asm volatile("" : "+v"(tidv));
                    if (kt + 2 < ntile) attn_load_tile(KVB, b, h, t, kt + 2, tidv, kregA, vregA);
                    attn_tile(KNB(0), VTB(0), Qf, tidv, kt * 64, q0w, qpos, c2, m, lsum, O);
                    attn_store_tile(KNB(1), VTB(1), tidv, kregB, vregB);
                    __syncthreads();
                    asm volatile("" : "+v"(tidv));
                    if (kt + 3 < ntile) attn_load_tile(KVB, b, h, t, kt + 3, tidv, kregB, vregB);
                    attn_tile(KNB(1), VTB(1), Qf, tidv, kt * 64 + 64, q0w, qpos, c2, m, lsum, O);
                    if (kt + 2 < ntile) attn_store_tile(KNB(0), VTB(0), tidv, kregA, vregA);
                    __syncthreads();
                }
                lsum += __shfl_xor(lsum, 32);
                const float inv = 1.0f / lsum;
                int te = c.tid; asm volatile("" : "+v"(te));
                const unsigned o1off = (unsigned)(te & 63), aoff = (unsigned)((te & 31) * DM + 4 * ((te >> 5) & 1));
                if (t == 0) {
#pragma unroll
                    for (int et = 0; et < 4; ++et)
#pragma unroll
                        for (int q = 0; q < 4; ++q) { O1S[((et * 4 + q) * 2) * 64 + o1off] = cvtpk(O[et][4 * q] * inv, O[et][4 * q + 1] * inv); O1S[((et * 4 + q) * 2 + 1) * 64 + o1off] = cvtpk(O[et][4 * q + 2] * inv, O[et][4 * q + 3] * inv); }
                } else {
                    float s1 = 0.f, s2 = 0.f;
                    { const float* lq1 = inp(c, 10) + j * 64; const float* lk1 = inp(c, 11) + j * 64; const float* lq2 = inp(c, 12) + j * 64; const float* lk2 = inp(c, 13) + j * 64;
#pragma unroll 4
                      for (int d = 0; d < 64; ++d) { s1 += lq1[d] * lk1[d]; s2 += lq2[d] * lk2[d]; } }
                    const float lam = __expf(s1) - __expf(s2) + lambda_init(i);
                    float ssq = 0.f; const float li = lam * inv;
#pragma unroll
                    for (int et = 0; et < 4; ++et)
#pragma unroll
                        for (int q = 0; q < 4; ++q) { const unsigned w0 = O1S[((et * 4 + q) * 2) * 64 + o1off], w1 = O1S[((et * 4 + q) * 2 + 1) * 64 + o1off]; const f32x4 o1 = (f32x4){bflo(w0), bfhi(w0), bflo(w1), bfhi(w1)};
#pragma unroll
                            for (int e = 0; e < 4; ++e) { const float v = o1[e] - li * O[et][4 * q + e]; O[et][4 * q + e] = v; ssq += v * v; } asm volatile("" ::: "memory"); }
                    ssq += __shfl_xor(ssq, 32);
                    const float rstd = rsqrtf(ssq * (1.0f / 128.0f) + EPS);
#pragma unroll
                    for (int et = 0; et < 4; ++et)
#pragma unroll
                        for (int q = 0; q < 4; ++q) { u32x2 o; o.x = cvtpk(O[et][4 * q] * rstd, O[et][4 * q + 1] * rstd); o.y = cvtpk(O[et][4 * q + 2] * rstd, O[et][4 * q + 3] * rstd);
                            *(u32x2*)(obase + et * 32 + 8 * q + aoff) = o; asm volatile("" ::: "memory"); }
                }
            }
        }
    }
}

#define XB_TMO      128
#define XB_XCNT(j)  (256  + 64 * (j))
#define XB_XSUB(j)  (1280 + 64 * (j))
#define XB_XGEN(j)  (2304 + 64 * (j))
#define XB_TOP      3328
#define XB_TOPGEN   3392
#define XCD_BAR_WORDS 3456
#define XB_SPIN_CAP (1u << 18)

__device__ __forceinline__ unsigned xb_ld(unsigned* p)              { return __hip_atomic_load(p, __ATOMIC_RELAXED, __HIP_MEMORY_SCOPE_AGENT); }
__device__ __forceinline__ unsigned xb_add(unsigned* p, unsigned v) { return __hip_atomic_fetch_add(p, v, __ATOMIC_RELAXED, __HIP_MEMORY_SCOPE_AGENT); }
__device__ __forceinline__ unsigned xb_xcc_id() { return (unsigned)__builtin_amdgcn_s_getreg((3 << 11) | 20) & 0xFu; }
#define XB_SPIN(cond, bar) do { unsigned _sp = 0; while (cond) { __builtin_amdgcn_s_sleep(1); \
    if ((++_sp & 255u) == 0u) { if (xb_ld(&(bar)[XB_TMO])) break; if (_sp > XB_SPIN_CAP) { atomicAdd(&(bar)[XB_TMO], 1u); break; } } } } while (0)

struct XcdBarrier {
    unsigned* bar; unsigned x;
    volatile LAS unsigned* st;
};

__device__ __forceinline__ XcdBarrier xcd_barrier_post(unsigned* bar, volatile LAS unsigned* st) {
    XcdBarrier b; b.bar = bar; b.x = xb_xcc_id(); b.st = st;
    if (threadIdx.x == 0) (void)xb_add(&bar[XB_XCNT(b.x)], 1u);
    return b;
}
__device__ __forceinline__ void xcd_barrier_complete(unsigned* bar, unsigned x, unsigned& nloc, unsigned& nx) {
    const unsigned G = gridDim.x * gridDim.y * gridDim.z;
    unsigned sum, cnt, mine, sp = 0u;
    for (;;) {
        sum = 0u; cnt = 0u; mine = 0u;
#pragma unroll
        for (unsigned j = 0; j < 16; ++j) { const unsigned c = xb_ld(&bar[XB_XCNT(j)]); sum += c; cnt += (c > 0u) ? 1u : 0u; mine = (j == x) ? c : mine; }
        if (sum == G) break;
        __builtin_amdgcn_s_sleep(1);
        if ((++sp & 255u) == 0u) { if (xb_ld(&bar[XB_TMO])) break; if (sp > XB_SPIN_CAP) { atomicAdd(&bar[XB_TMO], 1u); break; } }
    }
    nloc = mine > 0u ? mine : 1u; nx = cnt > 0u ? cnt : 1u;
}

__device__ __forceinline__ void xcd_barrier(const XcdBarrier& b) {
    asm volatile("s_waitcnt vmcnt(0)" ::: "memory");
    __syncthreads();
    if (threadIdx.x == 0) {
        unsigned* bar = b.bar;
        __builtin_amdgcn_s_waitcnt(0);
        unsigned nloc = b.st[0], nx = b.st[1];
        if (nloc == 0u) { xcd_barrier_complete(bar, b.x, nloc, nx); b.st[0] = nloc; b.st[1] = nx; }
        const unsigned old = xb_add(&bar[XB_XSUB(b.x)], 1u);
        const unsigned gen = old / nloc;
        if (old + 1u == (gen + 1u) * nloc) {
            __builtin_amdgcn_fence(__ATOMIC_RELEASE, "agent");
            asm volatile("s_waitcnt vmcnt(0)" ::: "memory");
            const unsigned og = xb_add(&bar[XB_TOP], 1u);
            const unsigned tg = og / nx;
            if (og + 1u == (tg + 1u) * nx) xb_add(&bar[XB_TOPGEN], 1u);
            else XB_SPIN(xb_ld(&bar[XB_TOPGEN]) == tg, bar);
            __builtin_amdgcn_fence(__ATOMIC_ACQUIRE, "agent");
            xb_add(&bar[XB_XGEN(b.x)], 1u);
            asm volatile("s_waitcnt vmcnt(0)" ::: "memory");
        } else {
            XB_SPIN(xb_ld(&bar[XB_XGEN(b.x)]) == gen, bar);
            __builtin_amdgcn_fence(__ATOMIC_ACQUIRE, "agent");
            asm volatile("s_waitcnt vmcnt(0)" ::: "memory");
        }
    }
    __syncthreads();
}


struct Args { const float* in[24]; float* out; unsigned char* ws; };
__global__ void __launch_bounds__(512, 2) hybrid_fwd(Args a) {
    extern __shared__ __attribute__((aligned(16))) unsigned char lds_raw[];
    cg::grid_group grid = cg::this_grid();
    Ctx c;
    c.out = a.out; c.ws = a.ws; c.lds = (LAS unsigned char*)lds_raw;
    if (threadIdx.x == 0) {
#pragma unroll
        for (int k = 0; k < 24; ++k) ((LAS unsigned long long*)(c.lds + PTR_OFF))[k] = (unsigned long long)a.in[k];
        ((LAS unsigned*)(c.lds + PTR_OFF + 192))[0] = 0u; ((LAS unsigned*)(c.lds + PTR_OFF + 192))[1] = 0u;
    }
    unsigned* barw = (unsigned*)(c.ws + WS_BAR);
    if (blockIdx.x == 0) for (int k = threadIdx.x; k < XCD_BAR_WORDS; k += 512) __hip_atomic_store(barw + k, 0u, __ATOMIC_RELAXED, __HIP_MEMORY_SCOPE_AGENT);
    __syncthreads();
    c.ngw = gridDim.x * 8;
#define REFRESH() do { int t_ = threadIdx.x; asm volatile("" : "+v"(t_)); int b_ = blockIdx.x; asm volatile("" : "+s"(b_)); c.tid = t_; c.lane = t_ & 63; \
        c.wid = __builtin_amdgcn_readfirstlane(t_ >> 6); c.bid = b_; c.gw = b_ * 8 + c.wid; } while (0)
    REFRESH();
    bf16_t* W1 = (bf16_t*)(c.ws + WS_W1); bf16_t* W2 = (bf16_t*)(c.ws + WS_W2); bf16_t* XN = (bf16_t*)(c.ws + WS_XN); bf16_t* Mb = (bf16_t*)(c.ws + WS_M);
    bf16_t* BIG = (bf16_t*)(c.ws + WS_BIG); bf16_t* ACT = (bf16_t*)(c.ws + WS_ACT); bf16_t* Yb = (bf16_t*)(c.ws + WS_Y); float* DT = (float*)(c.ws + WS_DT);

#ifdef PROBE_CAT
    unsigned long long tacc[8] = {0, 0, 0, 0, 0, 0, 0, 0}; unsigned long long tprev = __builtin_amdgcn_s_memrealtime();
#define TICK(cat) do { const unsigned long long tn_ = __builtin_amdgcn_s_memrealtime(); tacc[cat] += tn_ - tprev; tprev = tn_; } while (0)
#else
#define TICK(cat) do { } while (0)
#endif
    if (PMASK & 1) rowwise_phase(c, inp(c, 0), nullptr, nullptr, nullptr, nullptr, XN, false);
    REFRESH();
    if (PMASK & 2) convert_phase(c, 0, 0);
    TICK(5);
    grid.sync();
    const XcdBarrier xbar = xcd_barrier_post(barw, (volatile LAS unsigned*)(c.lds + PTR_OFF + 192));
#define GSYNC() xcd_barrier(xbar)
    TICK(7);
#pragma unroll 1
    for (int sl = 0; sl < 8; ++sl) {
        const int i = sl >> 1, j = i >> 1; const bool ffn = sl & 1, ssm = !(i & 1);
        REFRESH();
        if (PMASK & 4) {
            const int N = ffn ? NUP : (ssm ? NPROJ : NQKV), nmain = N;
            pg8::Gemm g{XN, W1, MROWS, N, DM, DM}; pg8::StaticOrder S; S.init(MROWS, N, (int)gridDim.x, c.bid);
            pg8::EpiStore E{BIG, nmain, nmain, nullptr, (!ffn && ssm) ? DIN : 0, (!ffn && !ssm) ? (bf16_t*)(c.ws + WS_KVB) : nullptr, ffn ? 1 : 0};
            for (int rp = 0; rp < NREP(4); ++rp) pg8::gemm_phase<pg8::EpiStore, pg8::StaticOrder, false, true>(c.lds, g, S, E);
            if (!ffn && ssm) dt_proj_phase(c, XN, W1, DT, inp(c, 4) + j * 32);
        }
        TICK(0);
        GSYNC();
        TICK(7);
        REFRESH();
        if (ffn) { for (int rp = 0; rp < NREP(8); ++rp) ffn_gate_phase(c, i); TICK(4); }
        else if (ssm) { for (int rp = 0; rp < NREP(16); ++rp) ssd_states_phase(c, j); TICK(2); GSYNC(); TICK(7); REFRESH(); if (PMASK & 32) ssd_scan_phase(c); TICK(6); GSYNC(); TICK(7); REFRESH(); for (int rp = 0; rp < NREP(64); ++rp) ssd_out_phase(c, j); TICK(3); }
        else { for (int rp = 0; rp < NREP(128); ++rp) attn_phase(c, i); TICK(1); }
        if (DUP & 256) { for (int rp = 0; rp < 4; ++rp) GSYNC(); }
        GSYNC();
        TICK(7);
        REFRESH();
        if (PMASK & 4) {
            const int K = ffn ? DFF : (ssm ? DIN : DM); const bf16_t* A = ffn ? ACT : Yb;
            pg8::Gemm g{A, W2, MROWS, DM, K, K}; pg8::StaticOrder S; S.init(MROWS, DM, (int)gridDim.x, c.bid);
            pg8::EpiStore E{Mb, DM, DM, nullptr, 0, nullptr, 0};
            for (int rp = 0; rp < NREP(512); ++rp) pg8::gemm_phase<pg8::EpiStore, pg8::StaticOrder, true, true>(c.lds, g, S, E);
        }
        TICK(0);
        GSYNC();
        TICK(7);
        REFRESH();
        if (PMASK & 1) rowwise_phase(c, nullptr, Mb, (ffn ? inp(c, 19) : inp(c, 17)) + i * DM, (sl == 0) ? inp(c, 0) : (const float*)c.out, c.out, XN, sl == 7);
        REFRESH();
        if (PMASK & 2) { if (!ffn) convert_phase(c, 2, i);
        else if (i < 3) convert_phase(c, ((i + 1) & 1) ? 1 : 0, i + 1); }
        TICK(5);
        if (sl < 7) { GSYNC(); TICK(7); }
    }
#ifdef PROBE_CAT
    if (blockIdx.x == 0 && threadIdx.x == 0) c.out[0] = 10000.0f + (float)(tacc[PROBE_CAT] / 100ull);
#endif
}

extern "C" void kernel_launch(void* const* d_in, const int* in_sizes, int n_in, void* d_out, int out_size, void* d_ws, size_t ws_size, hipStream_t stream) {
    static int grid_blocks = 0;
    if (grid_blocks == 0) {
        if (n_in != 24 || in_sizes[0] != MROWS * DM || out_size != MROWS * DM || ws_size < WS_END) {
            fprintf(stderr, "kernel_launch: unexpected problem (n_in %d, in0 %d, out %d, ws %zu < %zu?); nothing launched\n", n_in, n_in > 0 ? in_sizes[0] : -1, out_size, ws_size, (size_t)WS_END); grid_blocks = -1; return; }
        int dev = 0, cus = 0, per_cu = 0;
        hipGetDevice(&dev); hipDeviceGetAttribute(&cus, hipDeviceAttributeMultiprocessorCount, dev);
        if (hipFuncSetAttribute((const void*)hybrid_fwd, hipFuncAttributeMaxDynamicSharedMemorySize, LDS_BYTES) != hipSuccess) { fprintf(stderr, "kernel_launch: hipFuncSetAttribute failed\n"); grid_blocks = -1; return; }
        if (hipOccupancyMaxActiveBlocksPerMultiprocessor(&per_cu, (const void*)hybrid_fwd, 512, LDS_BYTES) != hipSuccess || per_cu < 1) { fprintf(stderr, "kernel_launch: occupancy query says %d\n", per_cu); per_cu = 1; }
        (void)hipGetLastError();
        grid_blocks = cus * (per_cu > 1 ? 1 : per_cu);
    }
    if (grid_blocks < 0) return;
    Args a{};
    for (int k = 0; k < 24; ++k) a.in[k] = (const float*)d_in[k];
    a.out = (float*)d_out; a.ws = (unsigned char*)d_ws;
    void* args[] = {&a};
    hipError_t e = hipLaunchCooperativeKernel((const void*)hybrid_fwd, dim3(grid_blocks), dim3(512), args, LDS_BYTES, stream);
    if (e != hipSuccess) fprintf(stderr, "kernel_launch: cooperative launch failed: %s (grid %d)\n", hipGetErrorString(e), grid_blocks);
}
```
